# Optimizing an MI355X kernel written in HIP

```python
import math
import jax, jax.numpy as jnp
from jax import lax
import numpy as np

D_MODEL = 2048
BATCH = 2
SEQ = 16384
DEPTH = 2

GRID_W = 64
CTX_LEN = 256
N_MIXERS = 2
EPS = 1e-6
GLA_HEADS = 4
GLA_KEY_DIM = D_MODEL // 2
GLA_VAL_DIM = D_MODEL
GLA_DK = GLA_KEY_DIM // GLA_HEADS
GLA_DV = GLA_VAL_DIM // GLA_HEADS
GLA_GATE_RANK = 16
GLA_GATE_NORM = 16.0
GLA_CHUNK = 64
GLA_IN_DIM = 2 * GLA_KEY_DIM + 2 * GLA_VAL_DIM
DIFF_HEAD_DIM = 128
DIFF_HEADS = D_MODEL // (2 * DIFF_HEAD_DIM)
DIFF_VAL_DIM = 2 * DIFF_HEAD_DIM
DIFF_WIDTH = DIFF_HEADS * DIFF_VAL_DIM
DIFF_IN_DIM = 4 * DIFF_WIDTH
Q_BLOCK = 128
ROPE_BASE = 10000.0

kernel_name = "hybrid_gla_diffattn_prefix_dit"


def rmsnorm(x, w):
    xf = x.astype(jnp.float32)
    y = xf * lax.rsqrt(jnp.mean(xf * xf, axis=-1, keepdims=True) + EPS)
    return (y * w.astype(jnp.float32)).astype(x.dtype)


def adaln(cond, w, b):
    m = jax.nn.silu(cond) @ w + b
    return jnp.split(m, 3, axis=-1)


def axial_rope_tables(n_tokens):
    rows_n = n_tokens // GRID_W
    row = jnp.repeat(jnp.arange(rows_n), GRID_W).astype(jnp.float32)
    col = jnp.tile(jnp.arange(GRID_W), rows_n).astype(jnp.float32)
    half = DIFF_HEAD_DIM // 2
    inv_freq = ROPE_BASE ** (-jnp.arange(0, half, 2, dtype=jnp.float32) / half)
    ang_r = row[:, None] * inv_freq
    ang_c = col[:, None] * inv_freq
    ang = jnp.concatenate([ang_r, ang_r, ang_c, ang_c], axis=-1)
    return jnp.cos(ang), jnp.sin(ang)


def apply_axial_rope(t, cos, sin):
    q4 = DIFF_HEAD_DIM // 4
    x1, x2, x3, x4 = t[..., :q4], t[..., q4:2 * q4], t[..., 2 * q4:3 * q4], t[..., 3 * q4:]
    rot = jnp.concatenate([-x2, x1, -x4, x3], axis=-1)
    cb = cos[None, :, None, None, :]
    sb = sin[None, :, None, None, :]
    return (t * cb + rot * sb).astype(t.dtype)


def gla_scan(q, k, v, log_a, s0):
    b_, t_, h_, _ = q.shape
    dv = v.shape[-1]
    n = t_ // GLA_CHUNK

    def chunks(t):
        return t.astype(jnp.float32).reshape(b_, n, GLA_CHUNK, h_, t.shape[-1]).transpose(1, 0, 3, 2, 4)

    lower = jnp.tril(jnp.ones((GLA_CHUNK, GLA_CHUNK), dtype=bool))

    def step(S, inp):
        qc, kc, vc, ac = inp
        bcum = jnp.cumsum(ac, axis=-2)
        o_inter = jnp.einsum('bhid,bhde->bhie', qc * jnp.exp(bcum), S)
        rel = bcum[:, :, :, None, :] - bcum[:, :, None, :, :]
        decay = jnp.exp(jnp.where(lower[:, :, None], rel, -jnp.inf))
        scores = jnp.einsum('bhid,bhjd,bhijd->bhij', qc, kc, decay)
        o_intra = jnp.einsum('bhij,bhje->bhie', scores, vc)
        b_last = bcum[:, :, -1:, :]
        S_new = jnp.exp(b_last[:, :, 0, :])[..., None] * S + jnp.einsum(
            'bhjd,bhje->bhde', kc * jnp.exp(b_last - bcum), vc)
        return S_new, o_inter + o_intra

    s_fin, o = lax.scan(step, s0, (chunks(q), chunks(k), chunks(v), chunks(log_a)))
    o = o.transpose(1, 0, 3, 2, 4).reshape(b_, t_, h_, dv)
    return o, s_fin


def gla_bidir(q, k, v, la_f, la_b, s0_f, s0_b):
    o_f, s_f = gla_scan(q, k, v, la_f, s0_f)
    fl = lambda t: jnp.flip(t, axis=1)
    o_b, s_b = gla_scan(fl(q), fl(k), fl(v), fl(la_b), s0_b)
    return o_f + fl(o_b), s_f, s_b


def gla_mixer(h, hc, w_in, gate_a1, gate_a2, gate_b, gn_w, w_out, need_ctx):
    def project(t):
        bt, tt = t.shape[:2]
        p = t @ w_in
        q, k, v, g = jnp.split(p, [GLA_KEY_DIM, 2 * GLA_KEY_DIM, 2 * GLA_KEY_DIM + GLA_VAL_DIM], axis=-1)
        q = q.reshape(bt, tt, GLA_HEADS, GLA_DK) * (GLA_DK ** -0.5)
        k = k.reshape(bt, tt, GLA_HEADS, GLA_DK)
        v = v.reshape(bt, tt, GLA_HEADS, GLA_DV)
        tf = t.astype(jnp.float32)
        las = [(jax.nn.log_sigmoid((tf @ gate_a1[d]) @ gate_a2[d] + gate_b[d]) / GLA_GATE_NORM
                ).reshape(bt, tt, GLA_HEADS, GLA_DK) for d in range(2)]
        return q, k, v, g, las[0], las[1]

    def finish(o, g):
        bt, tt = o.shape[:2]
        o = rmsnorm(o, gn_w).reshape(bt, tt, GLA_VAL_DIM).astype(g.dtype)
        return (o * jax.nn.silu(g)) @ w_out

    b_ = h.shape[0]
    zeros = jnp.zeros((b_, GLA_HEADS, GLA_DK, GLA_DV), jnp.float32)
    qc, kc, vc, gc, lafc, labc = project(hc)
    o_c, s_f, s_b = gla_bidir(qc, kc, vc, lafc, labc, zeros, zeros)
    q, k, v, g, laf, lab = project(h)
    o, _, _ = gla_bidir(q, k, v, laf, lab, s_f, s_b)
    y = finish(o, g)
    yc = finish(o_c, gc) if need_ctx else None
    return y, yc


def diff_attend(qb, k_all, v_all, lam):
    s = jnp.einsum('bqhmd,bkhmd->bhmqk', qb, k_all) * (DIFF_HEAD_DIM ** -0.5)
    p = jax.nn.softmax(s, axis=-1)
    a = p[:, :, 0] - lam * p[:, :, 1]
    return jnp.einsum('bhqk,bkhe->bqhe', a, v_all)


def diff_mixer(h, hc, w_in, qn_w, kn_w, lam_v, subln_w, w_out, lambda_init, cos, sin, need_ctx):
    def project(t):
        bt, tt = t.shape[:2]
        q, k, v, g = jnp.split(t @ w_in, 4, axis=-1)
        q = rmsnorm(q.reshape(bt, tt, DIFF_HEADS, 2, DIFF_HEAD_DIM), qn_w)
        k = rmsnorm(k.reshape(bt, tt, DIFF_HEADS, 2, DIFF_HEAD_DIM), kn_w)
        v = v.reshape(bt, tt, DIFF_HEADS, DIFF_VAL_DIM)
        return q, k, v, g

    lv = lam_v.astype(jnp.float32)
    lam = jnp.exp(jnp.sum(lv[0] * lv[1])) - jnp.exp(jnp.sum(lv[2] * lv[3])) + lambda_init

    q, k, v, g = project(h)
    q = apply_axial_rope(q, cos, sin)
    k = apply_axial_rope(k, cos, sin)
    qc, kc, vc, gc = project(hc)
    f32 = jnp.float32
    k_all = jnp.concatenate([k, kc], axis=1).astype(f32)
    v_all = jnp.concatenate([v, vc], axis=1).astype(f32)

    b_, s_ = h.shape[:2]
    nblk = s_ // Q_BLOCK
    q_blocks = q.astype(f32).reshape(b_, nblk, Q_BLOCK, DIFF_HEADS, 2, DIFF_HEAD_DIM).transpose(1, 0, 2, 3, 4, 5)
    o = lax.map(lambda qb: diff_attend(qb, k_all, v_all, lam), q_blocks)
    o = o.transpose(1, 0, 2, 3, 4).reshape(b_, s_, DIFF_HEADS, DIFF_VAL_DIM)

    def finish(o, g):
        bt, tt = o.shape[:2]
        o = (rmsnorm(o, subln_w) * (1.0 - lambda_init)).reshape(bt, tt, DIFF_WIDTH).astype(g.dtype)
        return (o * jax.nn.silu(g)) @ w_out

    y = finish(o, g)
    yc = None
    if need_ctx:
        o_c = diff_attend(qc.astype(f32), kc.astype(f32), vc.astype(f32), lam)
        yc = finish(o_c, gc)
    return y, yc


def setup_inputs(seed: int = 0) -> dict:
    key = jax.random.key(seed)
    ks = jax.random.split(key, 24)
    n_a = (DEPTH + N_MIXERS - 1) // N_MIXERS
    n_b = DEPTH // N_MIXERS
    nrm = jax.random.normal
    f32 = jnp.float32
    D = D_MODEL
    return {
        "x": nrm(ks[0], (BATCH, SEQ, D), f32),
        "c": nrm(ks[1], (BATCH, D), f32),
        "ctx": nrm(ks[2], (BATCH, CTX_LEN, D), f32),
        "c_ctx": nrm(ks[3], (D,), f32),
        "norm_w": 1.0 + 0.02 * nrm(ks[4], (DEPTH, D), f32),
        "ada_w": nrm(ks[5], (DEPTH, D, 3 * D), f32) * D ** -0.5,
        "ada_b": 0.02 * nrm(ks[6], (DEPTH, 3 * D), f32),
        "gla_w_in": nrm(ks[7], (n_a, D, GLA_IN_DIM), f32) * D ** -0.5,
        "gla_gate_a1": nrm(ks[8], (n_a, 2, D, GLA_GATE_RANK), f32) * D ** -0.5,
        "gla_gate_a2": nrm(ks[9], (n_a, 2, GLA_GATE_RANK, GLA_KEY_DIM), f32) * GLA_GATE_RANK ** -0.5,
        "gla_gate_b": 0.1 * nrm(ks[10], (n_a, 2, GLA_KEY_DIM), f32),
        "gla_gn_w": 1.0 + 0.02 * nrm(ks[11], (n_a, GLA_DV), f32),
        "gla_w_out": nrm(ks[12], (n_a, GLA_VAL_DIM, D), f32) * GLA_VAL_DIM ** -0.5,
        "diff_w_in": nrm(ks[13], (n_b, D, DIFF_IN_DIM), f32) * D ** -0.5,
        "diff_qn_w": 1.0 + 0.02 * nrm(ks[14], (n_b, 2, DIFF_HEAD_DIM), f32),
        "diff_kn_w": 1.0 + 0.02 * nrm(ks[15], (n_b, 2, DIFF_HEAD_DIM), f32),
        "diff_lam": 0.1 * nrm(ks[16], (n_b, 4, DIFF_HEAD_DIM), f32),
        "diff_subln_w": 1.0 + 0.02 * nrm(ks[17], (n_b, DIFF_VAL_DIM), f32),
        "diff_w_out": nrm(ks[18], (n_b, DIFF_WIDTH, D), f32) * DIFF_WIDTH ** -0.5,
    }


def reference(x, c, ctx, c_ctx, norm_w, ada_w, ada_b,
              gla_w_in, gla_gate_a1, gla_gate_a2, gla_gate_b, gla_gn_w, gla_w_out,
              diff_w_in, diff_qn_w, diff_kn_w, diff_lam, diff_subln_w, diff_w_out):
    cos, sin = axial_rope_tables(x.shape[1])
    for i in range(DEPTH):
        last = i == DEPTH - 1
        j = i // N_MIXERS
        shift, scale, gate = adaln(c, ada_w[i], ada_b[i])
        shift_c, scale_c, gate_c = adaln(c_ctx, ada_w[i], ada_b[i])
        h = rmsnorm(x, norm_w[i]) * (1.0 + scale[:, None]) + shift[:, None]
        hc = rmsnorm(ctx, norm_w[i]) * (1.0 + scale_c) + shift_c
        if i % N_MIXERS == 0:
            y, yc = gla_mixer(h, hc, gla_w_in[j], gla_gate_a1[j], gla_gate_a2[j], gla_gate_b[j],
                              gla_gn_w[j], gla_w_out[j], not last)
        else:
            lambda_init = 0.8 - 0.6 * math.exp(-0.3 * i)
            y, yc = diff_mixer(h, hc, diff_w_in[j], diff_qn_w[j], diff_kn_w[j], diff_lam[j],
                               diff_subln_w[j], diff_w_out[j], lambda_init, cos, sin, not last)
        x = x + gate[:, None] * y
        if not last:
            ctx = ctx + gate_c * yc
    return x
```

```cpp
#include <hip/hip_runtime.h>
#include <hip/hip_bf16.h>
#include <hip/hip_cooperative_groups.h>
#include <cstdio>
#include <cstdint>
namespace cg = cooperative_groups;
#ifndef MK_LAUNCHES
#define MK_LAUNCHES 1
#endif
namespace pg8 {
#define PG8_LAS __attribute__((address_space(3)))
typedef unsigned short bf16_t;
typedef short bf16x8 __attribute__((ext_vector_type(8)));
typedef float f32x4 __attribute__((ext_vector_type(4)));
typedef unsigned u32x4 __attribute__((ext_vector_type(4)));
constexpr int BM = 256, BK = 64, HALF = 128, HTB = HALF * BK * 2  , STAGE_BYTES = 8 * HTB, NXCD = 8, WGM = 8;

__host__ __device__ __forceinline__ int lds_byte(int r, int c) { const int st = (r >> 4) * 2 + (c >> 5), rr = r & 15, cc = c & 31, ob = rr * 64 + cc * 2; return st * 1024 + (ob ^ (((ob >> 9) & 1) << 5)); }
__host__ __device__ __forceinline__ void stage_rc(int b, int& R, int& C) { const int st = b / 1024, sb = b % 1024, swz = sb ^ (((sb >> 9) & 1) << 5); R = (st >> 1) * 16 + swz / 64; C = (st & 1) * 32 + (swz % 64) / 2; }
__host__ __device__ __forceinline__ int perm32(int rho) { const int n = rho >> 4, i = rho & 15; return 8 * (i >> 2) + 4 * n + (i & 3); }

struct Unit { int pm, pn; };
struct Gemm { const bf16_t* A; const bf16_t* Bt; int M, N, K; };

struct StaticOrder {
    int nM, nN, nwg, G, c;
    __host__ __device__ void init(int M, int N, int G_, int c_) { nM = M / BM; nN = N / BM; nwg = nM * nN; G = G_; c = c_; }
    __host__ __device__ bool next(int i, Unit& u) const {
        const long L = (long)i * G + c; if (L >= nwg) return false;
        int wgid = (int)L; { const int q = nwg / NXCD, r = nwg % NXCD, xcd = wgid % NXCD, off = wgid / NXCD; wgid = (xcd < r ? xcd * (q + 1) : r * (q + 1) + (xcd - r) * q) + off; }
        const int nig = WGM * nN, gid = wgid / nig, fm = gid * WGM, gsz = (nM - fm) < WGM ? (nM - fm) : WGM;
        u.pm = fm + ((wgid % nig) % gsz); u.pn = (wgid % nig) / gsz; return true;
    }
    __device__ __forceinline__ void a_ready(const Unit&) const {}
    __device__ __forceinline__ void done(const Unit&) const {}
};
__device__ __forceinline__ unsigned cvt_pk_bf16(float lo, float hi) { unsigned r; asm volatile("v_cvt_pk_bf16_f32 %0, %1, %2" : "=v"(r) : "v"(lo), "v"(hi)); return r; }
typedef float f32x2 __attribute__((ext_vector_type(2)));
typedef unsigned u32x2v __attribute__((ext_vector_type(2)));
typedef __bf16 bf16x2v_ __attribute__((ext_vector_type(2)));
typedef float f32x2v_ __attribute__((ext_vector_type(2)));
__device__ __forceinline__ unsigned cvt2v(float lo, float hi) { const f32x2v_ v = {lo, hi}; const bf16x2v_ b = __builtin_convertvector(v, bf16x2v_); return __builtin_bit_cast(unsigned, b); }
struct EpiIn {
    static constexpr bool PERM = true, AFTER_DRAIN = false;
    bf16_t* O; int ldc; int ncols_main; float* R; int qcols; float qscale;
    __device__ __forceinline__ void operator()(const f32x4 (&acc)[2][2][4][2], const Unit& u, int wr, int wc, int fr, int fq) const {
        const int row0 = u.pm * BM + wr * 64 + fr; const int colt = u.pn * BM;
        if (colt >= ncols_main) {
            if (wc == 0) {
#pragma unroll
                for (int ai = 0; ai < 2; ++ai)
#pragma unroll
                    for (int m = 0; m < 4; ++m) { float* rp = R + (size_t)(row0 + ai * HALF + m * 16) * 32 + 8 * fq;
                        *(f32x4*)(rp) = acc[ai][0][m][0]; *(f32x4*)(rp + 4) = acc[ai][0][m][1]; }
            }
            return;
        }
        const float sc = (colt < qcols) ? qscale : 1.f;
        const int col0 = colt + wc * 32 + 8 * fq;
#pragma unroll
        for (int ai = 0; ai < 2; ++ai)
#pragma unroll
            for (int m = 0; m < 4; ++m) { bf16_t* rowp = O + (size_t)(row0 + ai * HALF + m * 16) * ldc + col0;
#pragma unroll
                for (int bj = 0; bj < 2; ++bj) { const f32x4 v0 = acc[ai][bj][m][0] * sc, v1 = acc[ai][bj][m][1] * sc;
                    u32x4 w; w.x = cvt_pk_bf16(v0[0], v0[1]); w.y = cvt_pk_bf16(v0[2], v0[3]); w.z = cvt_pk_bf16(v1[0], v1[1]); w.w = cvt_pk_bf16(v1[2], v1[3]);
                    *(u32x4*)(rowp + bj * HALF) = w; } }
    }
};
struct EpiInD {
    static constexpr bool PERM = true, AFTER_DRAIN = false;
    bf16_t* QD; bf16_t* KD; bf16_t* VD; bf16_t* G;
    __device__ __forceinline__ void operator()(const f32x4 (&acc)[2][2][4][2], const Unit& u, int wr, int wc, int fr, int fq) const {
        const int b = u.pm / 65, t0 = (u.pm % 65) * 256 + wr * 64 + fr; const int reg = u.pn >> 3, h = u.pn & 7;
        const int cl = wc * 32 + 8 * fq;
#pragma unroll
        for (int ai = 0; ai < 2; ++ai)
#pragma unroll
            for (int m = 0; m < 4; ++m) { const int t = t0 + ai * HALF + m * 16;
#pragma unroll
                for (int bj = 0; bj < 2; ++bj) { const f32x4 v0 = acc[ai][bj][m][0], v1 = acc[ai][bj][m][1];
                    u32x4 w; w.x = cvt2v(v0[0], v0[1]); w.y = cvt2v(v0[2], v0[3]); w.z = cvt2v(v1[0], v1[1]); w.w = cvt2v(v1[2], v1[3]);
                    bf16_t* dst;
                    if (reg == 0)      dst = QD + ((((size_t)(b * 8 + h) * 2 + bj) * 16640 + t) * 128 + cl);
                    else if (reg == 1) dst = KD + ((((size_t)(b * 8 + h) * 2 + bj) * 16640 + t) * 128 + cl);
                    else if (reg == 2) dst = VD + (((size_t)(b * 8 + h) * 16640 + t) * 256 + bj * HALF + cl);
                    else               dst = G + ((size_t)(b * 16640 + t) * 2048 + h * 256 + bj * HALF + cl);
                    *(u32x4*)dst = w; } }
    }
};
struct EpiOut {
    static constexpr bool PERM = true, AFTER_DRAIN = false;
    const float* baseL; float* outL; const float* baseC; float* outC; const float* mods;
    __device__ __forceinline__ void operator()(const f32x4 (&acc)[2][2][4][2], const Unit& u, int wr, int wc, int fr, int fq) const {
        const int b = u.pm / 65, tt = u.pm % 65;
        const float* base; float* out; const float* g; size_t rbase;
        if (tt < 64) { base = baseL; out = outL; rbase = (size_t)(b * 64 + tt) * 256; g = mods + b * 6144 + 4096; }
        else { base = baseC; out = outC; rbase = (size_t)b * 256; g = mods + 2 * 6144 + 4096; }
        const int col0 = u.pn * BM + wc * 32 + 8 * fq;
#pragma unroll
        for (int bj = 0; bj < 2; ++bj) { const f32x4 g0 = *(const f32x4*)(g + col0 + bj * HALF), g1 = *(const f32x4*)(g + col0 + bj * HALF + 4);
#pragma unroll
            for (int ai = 0; ai < 2; ++ai)
#pragma unroll
                for (int m = 0; m < 4; ++m) { const size_t off = (rbase + ai * HALF + wr * 64 + m * 16 + fr) * 2048 + col0 + bj * HALF;
                    const f32x4 b0 = *(const f32x4*)(base + off), b1 = *(const f32x4*)(base + off + 4);
                    *(f32x4*)(out + off) = b0 + g0 * acc[ai][bj][m][0]; *(f32x4*)(out + off + 4) = b1 + g1 * acc[ai][bj][m][1]; } }
    }
};
struct LatentOrder {
    StaticOrder S;
    __device__ void init(int G_, int c_) { S.init(32768, 2048, G_, c_); }
    __device__ bool next(int i, Unit& u) const { if (!S.next(i, u)) return false; u.pm += (u.pm >= 64) ? 1 : 0; return true; }
    __device__ __forceinline__ void a_ready(const Unit&) const {}
    __device__ __forceinline__ void done(const Unit&) const {}
};
template <class Epi, class Sched, bool ALIGN_EPI = false, bool SP2 = false>
__device__ __forceinline__ void gemm_phase(PG8_LAS unsigned char* lds, const Gemm g, const Sched& S, const Epi& E) {
    const int tid = threadIdx.x, wid = __builtin_amdgcn_readfirstlane(tid >> 6), lane = tid & 63, wr = wid >> 2, wc = wid & 3, fr = lane & 15, fq = lane >> 4;
    const int K = g.K, nt = K / BK;
    unsigned voffA[2], voffB[2];
#pragma unroll
    for (int i = 0; i < 2; ++i) { int R, C; stage_rc(tid * 16 + i * 8192, R, C); const int Rb = Epi::PERM ? ((R & ~31) + perm32(R & 31)) : R;
        voffA[i] = (unsigned)(R * K + C) * 2u; voffB[i] = (unsigned)(Rb * K + C) * 2u; }
    const size_t kstep = (size_t)(BK * 2);
    const size_t hstep = (size_t)HALF * K * 2;
    const size_t tstep = 2 * hstep;
    const unsigned ldsw = (unsigned)wid * 1024u;
    const int aoff = lds_byte(wr * 64 + fr, fq * 8), boff = lds_byte(wc * 32 + fr, fq * 8);
#define PG8_SA(b, h) (((b) * 2 + (h)) * HTB)
#define PG8_SB(b, h) ((4 + (b) * 2 + (h)) * HTB)
#define PG8_STAGE(bufoff, gbase, voff) do { _Pragma("unroll") for (int _i = 0; _i < 2; ++_i) \
        __builtin_amdgcn_global_load_lds((const unsigned*)((const char*)(gbase) + (voff)[_i]), (PG8_LAS unsigned*)(lds + (bufoff) + ldsw + _i * 8192), 16, 0, 0); } while (0)
#define PG8_LDA(dst, b, h) do { _Pragma("unroll") for (int m = 0; m < 4; ++m) _Pragma("unroll") for (int k = 0; k < 2; ++k) dst[m][k] = *(const PG8_LAS bf16x8*)(lds + PG8_SA(b, h) + aoff + m * 2048 + k * 1024); } while (0)
#define PG8_LDB(dst, b, h) do { _Pragma("unroll") for (int n = 0; n < 2; ++n) _Pragma("unroll") for (int k = 0; k < 2; ++k) dst[n][k] = *(const PG8_LAS bf16x8*)(lds + PG8_SB(b, h) + boff + n * 2048 + k * 1024); } while (0)
#define PG8_MMA(ai, bj, At, Bt) do { __builtin_amdgcn_s_setprio(1); _Pragma("unroll") for (int m = 0; m < 4; ++m) _Pragma("unroll") for (int n = 0; n < 2; ++n) _Pragma("unroll") for (int k = 0; k < 2; ++k) \
        acc[ai][bj][m][n] = __builtin_amdgcn_mfma_f32_16x16x32_bf16(Bt[n][k], At[m][k], acc[ai][bj][m][n], 0, 0, 0); __builtin_amdgcn_s_setprio(0); } while (0)
#define PG8_WAIT_V(n) asm volatile("s_waitcnt vmcnt(" #n ")" ::: "memory")
#define PG8_WAIT_L(n) asm volatile("s_waitcnt lgkmcnt(" #n ")" ::: "memory")
#define PG8_BAR __builtin_amdgcn_s_barrier()
#define PG8_SCHED __builtin_amdgcn_sched_barrier(0)
    Unit cur, nxt; int ui = 0;
    if (!S.next(0, cur)) return;
    f32x4 acc[2][2][4][2];
#pragma unroll
    for (int a = 0; a < 2; ++a)
#pragma unroll
        for (int b = 0; b < 2; ++b)
#pragma unroll
            for (int m = 0; m < 4; ++m)
#pragma unroll
                for (int n = 0; n < 2; ++n) acc[a][b][m][n] = (f32x4){0.f, 0.f, 0.f, 0.f};
    bf16x8 At[4][2], B0[2][2], B1[2][2];
    const char* cA = (const char*)g.A + (size_t)cur.pm * tstep; const char* cB = (const char*)g.Bt + (size_t)cur.pn * tstep;
    S.a_ready(cur);
    if constexpr (SP2) {
        PG8_STAGE(PG8_SB(0, 0), cB, voffB); PG8_STAGE(PG8_SB(0, 1), cB + hstep, voffB); PG8_STAGE(PG8_SA(0, 0), cA, voffA); PG8_STAGE(PG8_SA(0, 1), cA + hstep, voffA);
        if (wr == 1) PG8_BAR;
        PG8_WAIT_V(2); PG8_BAR;
        PG8_STAGE(PG8_SB(1, 0), cB + kstep, voffB); PG8_STAGE(PG8_SA(1, 0), cA + kstep, voffA); PG8_STAGE(PG8_SB(1, 1), cB + hstep + kstep, voffB);
        PG8_WAIT_V(6); PG8_BAR;
    } else {
        PG8_STAGE(PG8_SB(0, 0), cB, voffB); PG8_STAGE(PG8_SA(0, 0), cA, voffA); PG8_STAGE(PG8_SB(0, 1), cB + hstep, voffB); PG8_STAGE(PG8_SA(0, 1), cA + hstep, voffA);
        if (wr == 1) PG8_BAR;
        PG8_WAIT_V(4); PG8_BAR;
        PG8_STAGE(PG8_SB(1, 0), cB + kstep, voffB); PG8_STAGE(PG8_SA(1, 0), cA + kstep, voffA); PG8_STAGE(PG8_SB(1, 1), cB + hstep + kstep, voffB);
        PG8_WAIT_V(6); PG8_BAR;
    }
    for (;;) {
        const bool has_next = S.next(ui + 1, nxt);
        const char* nA = has_next ? (const char*)g.A + (size_t)nxt.pm * tstep : cA; const char* nB = has_next ? (const char*)g.Bt + (size_t)nxt.pn * tstep : cB;
        for (int t = 0; t < nt; t += 2) {
            const bool last = (t == nt - 2);
            const char* a1 = cA + (size_t)(t + 1) * kstep;
            const char* a2 = last ? nA : cA + (size_t)(t + 2) * kstep; const char* b2 = last ? nB : cB + (size_t)(t + 2) * kstep;
            const char* a3 = a2 + kstep; const char* b3 = b2 + kstep;
            if (last && has_next) S.a_ready(nxt);
            if constexpr (SP2) {
            PG8_LDB(B0, 0, 0); PG8_LDB(B1, 0, 1); PG8_SCHED; PG8_LDA(At, 0, 0); PG8_STAGE(PG8_SA(1, 1), a1 + hstep, voffA);
            PG8_WAIT_V(8); PG8_WAIT_L(0); PG8_BAR; PG8_MMA(0, 0, At, B0); PG8_MMA(0, 1, At, B1); PG8_BAR; PG8_SCHED;
            PG8_LDA(At, 0, 1); PG8_STAGE(PG8_SB(0, 0), b2, voffB); PG8_STAGE(PG8_SB(0, 1), b2 + hstep, voffB); PG8_STAGE(PG8_SA(0, 0), a2, voffA);
            PG8_WAIT_V(8); PG8_WAIT_L(0); PG8_BAR; PG8_MMA(1, 0, At, B0); PG8_MMA(1, 1, At, B1); PG8_BAR; PG8_SCHED;
            PG8_LDB(B0, 1, 0); PG8_LDB(B1, 1, 1); PG8_SCHED; PG8_LDA(At, 1, 0); PG8_STAGE(PG8_SA(0, 1), a2 + hstep, voffA);
            PG8_WAIT_V(8); PG8_WAIT_L(0); PG8_BAR; PG8_MMA(0, 0, At, B0); PG8_MMA(0, 1, At, B1); PG8_BAR; PG8_SCHED;
            PG8_LDA(At, 1, 1); PG8_STAGE(PG8_SB(1, 0), b3, voffB); PG8_STAGE(PG8_SB(1, 1), b3 + hstep, voffB); PG8_STAGE(PG8_SA(1, 0), a3, voffA);
            PG8_WAIT_V(8); PG8_WAIT_L(0); PG8_BAR; PG8_MMA(1, 0, At, B0); PG8_MMA(1, 1, At, B1); PG8_BAR; PG8_SCHED;
            } else {
            PG8_LDB(B0, 0, 0); PG8_SCHED; PG8_LDA(At, 0, 0); PG8_STAGE(PG8_SA(1, 1), a1 + hstep, voffA);
            PG8_WAIT_L(8); PG8_BAR; PG8_WAIT_L(0); PG8_MMA(0, 0, At, B0); PG8_BAR; PG8_SCHED;
            PG8_LDB(B1, 0, 1); PG8_STAGE(PG8_SB(0, 0), b2, voffB);
            PG8_BAR; PG8_WAIT_L(0); PG8_MMA(0, 1, At, B1); PG8_BAR;
            PG8_LDA(At, 0, 1); PG8_STAGE(PG8_SA(0, 0), a2, voffA);
            PG8_BAR; PG8_WAIT_L(0); PG8_MMA(1, 0, At, B0); PG8_BAR; PG8_SCHED;
            PG8_STAGE(PG8_SB(0, 1), b2 + hstep, voffB);
            PG8_WAIT_V(6); PG8_BAR; PG8_MMA(1, 1, At, B1); PG8_BAR;
            PG8_LDB(B0, 1, 0); PG8_SCHED; PG8_LDA(At, 1, 0); PG8_STAGE(PG8_SA(0, 1), a2 + hstep, voffA);
            PG8_WAIT_L(8); PG8_BAR; PG8_WAIT_L(0); PG8_MMA(0, 0, At, B0); PG8_BAR; PG8_SCHED;
            PG8_LDB(B1, 1, 1); PG8_STAGE(PG8_SB(1, 0), b3, voffB);
            PG8_BAR; PG8_WAIT_L(0); PG8_MMA(0, 1, At, B1); PG8_BAR;
            PG8_LDA(At, 1, 1); PG8_STAGE(PG8_SA(1, 0), a3, voffA);
            PG8_BAR; PG8_WAIT_L(0); PG8_MMA(1, 0, At, B0); PG8_BAR; PG8_SCHED;
            PG8_STAGE(PG8_SB(1, 1), b3 + hstep, voffB);
            PG8_WAIT_V(6); PG8_BAR; PG8_MMA(1, 1, At, B1); PG8_BAR;
            }
        }
        if constexpr (ALIGN_EPI) { if (wr == 0) PG8_BAR; }
        if constexpr (!Epi::AFTER_DRAIN) { E(acc, cur, wr, wc, fr, fq); S.done(cur); }
        if (!has_next) break;
#pragma unroll
        for (int a = 0; a < 2; ++a)
#pragma unroll
            for (int b = 0; b < 2; ++b)
#pragma unroll
                for (int m = 0; m < 4; ++m)
#pragma unroll
                    for (int n = 0; n < 2; ++n) acc[a][b][m][n] = (f32x4){0.f, 0.f, 0.f, 0.f};
        cur = nxt; cA = nA; cB = nB; ++ui;
        if constexpr (ALIGN_EPI) { if (wr == 1) PG8_BAR; }
    }
    PG8_WAIT_V(0);
    if constexpr (!ALIGN_EPI) { if (wr == 0) PG8_BAR; }
    PG8_BAR;
    if constexpr (Epi::AFTER_DRAIN) { E.fused(acc, cur, wr, wc, fr, fq, lds, wid, lane); S.done(cur); }
#undef PG8_SA
#undef PG8_SB
#undef PG8_STAGE
#undef PG8_LDA
#undef PG8_LDB
#undef PG8_MMA
#undef PG8_WAIT_V
#undef PG8_WAIT_L
#undef PG8_BAR
#undef PG8_SCHED
}
}
namespace attn {
using bf16 = __hip_bfloat16;
constexpr int   D = 128, NW = 8, QBLK = 32, KVBLK = 64;
constexpr float SCALE = 0.088388347648318440f;
constexpr float THR = 8.f;
constexpr int SDEPTH = 2;
constexpr int LDQ = 8192, LDK = 8192, LDO = 2048;
constexpr size_t SHM_V = KVBLK * D * 2, SHM_K = KVBLK * D * 2, SHM_ATTN = 2 * SHM_V + 2 * SHM_K + NW * 64 * 4;
typedef float f32x4v __attribute__((ext_vector_type(4)));
using bf16x8 = __attribute__((ext_vector_type(8))) short;
using s16x4  = __attribute__((ext_vector_type(4))) short;
using f32x16 = __attribute__((ext_vector_type(16))) float;
using f32x8  = __attribute__((ext_vector_type(8))) float;
using u32x4  = __attribute__((ext_vector_type(4))) unsigned;
#define KSWZ(row, colB) ((row) * 256 + ((colB) ^ (((row) & 7) << 4)))
#define SBAR() __builtin_amdgcn_sched_barrier(0)
__device__ __forceinline__ int crow(int r, int hi) { return (r & 3) + 8 * (r >> 2) + 4 * hi; }
__device__ __forceinline__ unsigned cvtpk(float lo, float hi) {
  unsigned r; asm volatile("v_cvt_pk_bf16_f32 %0, %1, %2" : "=v"(r) : "v"(lo), "v"(hi)); return r;
}
template <typename TIn> struct Stage;
template <> struct Stage<bf16>  { using T = bf16x8;
  __device__ static __forceinline__ T ld8(const bf16* p) { return *reinterpret_cast<const bf16x8*>(p); }
  __device__ static __forceinline__ bf16x8 tobf(T x) { return x; } };
template <> struct Stage<float> { using T = f32x8;
  __device__ static __forceinline__ T ld8(const float* p) { return *reinterpret_cast<const f32x8*>(p); }
  __device__ static __forceinline__ bf16x8 tobf(T x) {
    u32x4 w = {cvtpk(x[0], x[1]), cvtpk(x[2], x[3]), cvtpk(x[4], x[5]), cvtpk(x[6], x[7])}; return *reinterpret_cast<bf16x8*>(&w); } };

__device__ __forceinline__ void partialSM(f32x16& p0, f32x16& p1, float& m_reg, float& mn, float& alpha) {
  constexpr float C = SCALE * 1.4426950408889634f;
  float pmax = p0[0]; for (int r = 1; r < 16; ++r) pmax = fmaxf(pmax, p0[r]); for (int r = 0; r < 16; ++r) pmax = fmaxf(pmax, p1[r]);
  { auto rr = __builtin_amdgcn_permlane32_swap(__float_as_uint(pmax), __float_as_uint(pmax), false, false);
    pmax = fmaxf(__uint_as_float(rr[0]), __uint_as_float(rr[1])); }
  if (__builtin_expect(__all(pmax - m_reg <= THR / SCALE), 1)) { mn = m_reg; alpha = 1.f; }
  else { mn = fmaxf(m_reg, pmax); alpha = __builtin_amdgcn_exp2f((m_reg - mn) * C); m_reg = mn; }
  float mnC = -mn * C;
  for (int r = 0; r < 16; ++r) p0[r] = fmaf(p0[r], C, mnC); for (int r = 0; r < 16; ++r) p1[r] = fmaf(p1[r], C, mnC);
  for (int r = 0; r < 16; ++r) p0[r] = __builtin_amdgcn_exp2f(p0[r]);
}
__device__ __forceinline__ void finishSM(f32x16& p0, f32x16& p1, float alpha, float& l_reg, bf16x8& pa0, bf16x8& pa1, bf16x8& pa2, bf16x8& pa3) {
  for (int r = 0; r < 16; ++r) p1[r] = __builtin_amdgcn_exp2f(p1[r]);
  float ps = 0; for (int r = 0; r < 16; ++r) ps += p0[r]; for (int r = 0; r < 16; ++r) ps += p1[r];
  { auto rr = __builtin_amdgcn_permlane32_swap(__float_as_uint(ps), __float_as_uint(ps), false, false);
    ps = __uint_as_float(rr[0]) + __uint_as_float(rr[1]); }
  l_reg = l_reg * alpha + ps;
#define PK4(P, BASE, OUT) do { unsigned a0 = cvtpk(P[BASE + 0], P[BASE + 1]), a1 = cvtpk(P[BASE + 2], P[BASE + 3]);   \
    unsigned b0 = cvtpk(P[BASE + 4], P[BASE + 5]), b1 = cvtpk(P[BASE + 6], P[BASE + 7]);                              \
    auto r0 = __builtin_amdgcn_permlane32_swap(a0, b0, false, false); auto r1 = __builtin_amdgcn_permlane32_swap(a1, b1, false, false); \
    u32x4 w = {r0[0], r1[0], r0[1], r1[1]}; OUT = *reinterpret_cast<bf16x8*>(&w); } while (0)
  PK4(p0, 0, pa0); PK4(p0, 8, pa1); PK4(p1, 0, pa2); PK4(p1, 8, pa3);
#undef PK4
}
__device__ __forceinline__ void qkt(f32x16& p0, f32x16& p1, const bf16* Ks, const bf16x8* qr, int r32, int hi) {
  p0 = f32x16{}; p1 = f32x16{};
  for (int d0 = 0; d0 < 8; ++d0) { int cb = (d0 * 16 + hi * 8) * 2;
    bf16x8 b0 = *reinterpret_cast<const bf16x8*>((const char*)Ks + KSWZ(r32, cb));
    bf16x8 b1 = *reinterpret_cast<const bf16x8*>((const char*)Ks + KSWZ(32 + r32, cb));
    p0 = __builtin_amdgcn_mfma_f32_32x32x16_bf16(b0, qr[d0], p0, 0, 0, 0);
    p1 = __builtin_amdgcn_mfma_f32_32x32x16_bf16(b1, qr[d0], p1, 0, 0, 0); }
}
__device__ __forceinline__ int v_st(int k, int c) { const int kk = (k & ~0xC) | ((k & 4) << 1) | ((k & 8) >> 1); return ((kk >> 3) * 4 + (c >> 5)) * 512 + ((kk & 7) * 32 + (c & 31)) * 2; }
__device__ __forceinline__ int v_rd_base(int lane) { return ((lane & 3) << 3) | (((lane >> 2) & 3) << 6) | (((lane >> 4) & 1) << 5) | (((lane >> 5) & 1) << 8); }
constexpr int v_rd_off(int d0, int ks, int half) { return d0 * 512 + ks * 4096 + half * 2048; }
template <int OFF> __device__ __forceinline__ s16x4 tr_read(int vb) {
  s16x4 r; asm volatile("ds_read_b64_tr_b16 %0, %1 offset:%2" : "=&v"(r) : "v"(vb), "i"(OFF) : "memory"); return r;
}
template <int D0> __device__ __forceinline__ void pv_one(f32x16& od, int vb, bf16x8 pa0, bf16x8 pa1, bf16x8 pa2, bf16x8 pa3) {
  const s16x4 l0 = tr_read<v_rd_off(D0, 0, 0)>(vb), h0 = tr_read<v_rd_off(D0, 0, 1)>(vb), l1 = tr_read<v_rd_off(D0, 1, 0)>(vb), h1 = tr_read<v_rd_off(D0, 1, 1)>(vb);
  const s16x4 l2 = tr_read<v_rd_off(D0, 2, 0)>(vb), h2 = tr_read<v_rd_off(D0, 2, 1)>(vb), l3 = tr_read<v_rd_off(D0, 3, 0)>(vb), h3 = tr_read<v_rd_off(D0, 3, 1)>(vb);
  asm volatile("s_waitcnt lgkmcnt(0)" ::: "memory"); SBAR();
#define PK(L, H) (bf16x8){L[0], L[1], L[2], L[3], H[0], H[1], H[2], H[3]}
  od = __builtin_amdgcn_mfma_f32_32x32x16_bf16(pa0, PK(l0, h0), od, 0, 0, 0);
  od = __builtin_amdgcn_mfma_f32_32x32x16_bf16(pa1, PK(l1, h1), od, 0, 0, 0);
  od = __builtin_amdgcn_mfma_f32_32x32x16_bf16(pa2, PK(l2, h2), od, 0, 0, 0);
  od = __builtin_amdgcn_mfma_f32_32x32x16_bf16(pa3, PK(l3, h3), od, 0, 0, 0);
#undef PK
}
__device__ __forceinline__ void pv_d0(f32x16* o, int vb, bf16x8 pa0, bf16x8 pa1, bf16x8 pa2, bf16x8 pa3) {
  pv_one<0>(o[0], vb, pa0, pa1, pa2, pa3); pv_one<1>(o[1], vb, pa0, pa1, pa2, pa3); pv_one<2>(o[2], vb, pa0, pa1, pa2, pa3); pv_one<3>(o[3], vb, pa0, pa1, pa2, pa3);
}
template <int MODE>
__device__ __forceinline__ void attn_dense_body(const bf16* __restrict__ Qb, const bf16* __restrict__ Kh, const bf16* __restrict__ Vh,
                                                float* Ob, int seq, char* lds, float lam) {
  using St = Stage<bf16>; using SQ = Stage<bf16>;
  int tid_ = threadIdx.x; asm volatile("" : "+v"(tid_));
  const int tid = tid_, wid = tid >> 6, lane = tid & 63, r32 = lane & 31, hi = lane >> 5;
  bf16* V_lds = (bf16*)lds; bf16* K_lds = (bf16*)(lds + 2 * SHM_V);
  float* ws = (float*)(lds + 2 * SHM_V + 2 * SHM_K) + wid * 64; float* li_l = ws; float* al_l = ws + 32;
  float m_reg = -1e30f, l_reg = 0; f32x16 o[4] = {}; bf16x8 qr[8];
  const bf16* Qw = Qb + (long)(wid * QBLK + r32) * LDQ + hi * 8;
#pragma unroll
  for (int d0 = 0; d0 < 8; ++d0) qr[d0] = SQ::tobf(SQ::ld8(Qw + d0 * 16));
  const int sr = tid >> 4, sc = (tid & 15) * 8, vst0 = v_st(sr, sc), vst1 = v_st(32 + sr, sc);
  const int vb0 = (int)(uintptr_t)V_lds + v_rd_base(lane);
  struct { typename St::T vs0, vs1, ks0, ks1; } sr_[SDEPTH];
#define SLOAD(i, k0) do { sr_[i].vs0 = St::ld8(&Vh[(long)((k0) + sr) * LDK + sc]); sr_[i].vs1 = St::ld8(&Vh[(long)((k0) + 32 + sr) * LDK + sc]); \
    sr_[i].ks0 = St::ld8(&Kh[(long)((k0) + sr) * LDK + sc]); sr_[i].ks1 = St::ld8(&Kh[(long)((k0) + 32 + sr) * LDK + sc]); } while (0)
#define SWRITE(b, i) do { *(bf16x8*)((char*)V_lds + (b) * SHM_V + vst0) = St::tobf(sr_[i].vs0);          \
    *(bf16x8*)((char*)V_lds + (b) * SHM_V + vst1) = St::tobf(sr_[i].vs1); int kc = sc * 2;               \
    *(bf16x8*)((char*)K_lds + (b) * SHM_K + KSWZ(sr, kc)) = St::tobf(sr_[i].ks0);                       \
    *(bf16x8*)((char*)K_lds + (b) * SHM_K + KSWZ(32 + sr, kc)) = St::tobf(sr_[i].ks1); } while (0)
#define SWAIT() do { if constexpr (SDEPTH == 2) asm volatile("s_waitcnt vmcnt(4)" ::: "memory"); else asm volatile("s_waitcnt vmcnt(0)" ::: "memory"); } while (0)
#define RESC(a) do { if (__any((a) < 1.f)) { if (hi == 0) al_l[r32] = (a); asm volatile("s_waitcnt lgkmcnt(0)" ::: "memory"); \
    for (int d = 0; d < 4; ++d) for (int r = 0; r < 16; ++r) o[d][r] *= al_l[crow(r, hi)]; } } while (0)
  f32x16 pA0, pA1, pB0, pB1; float mnA, mnB, alA, alB; bf16x8 pa0, pa1, pa2, pa3; const int NT = seq / KVBLK;
  constexpr int SE = 0, SO = SDEPTH - 1;
  SLOAD(SE, 0); asm volatile("s_waitcnt vmcnt(0)" ::: "memory"); SWRITE(0, SE); __syncthreads();
  qkt(pA0, pA1, K_lds, qr, r32, hi); partialSM(pA0, pA1, m_reg, mnA, alA);
  SLOAD(SO, KVBLK); if constexpr (SDEPTH == 2) { if (2 < NT) SLOAD(SE, 2 * KVBLK); }
  SWAIT(); SWRITE(1, SO); __syncthreads();
  for (int j = 1; j + 1 < NT; j += 2) {
    SBAR(); qkt(pB0, pB1, (bf16*)((char*)K_lds + SHM_K), qr, r32, hi);
    finishSM(pA0, pA1, alA, l_reg, pa0, pa1, pa2, pa3); SBAR();
    SLOAD(SO, (j + SDEPTH) * KVBLK); SBAR();
    pv_d0(o, vb0, pa0, pa1, pa2, pa3); partialSM(pB0, pB1, m_reg, mnB, alB);
    __syncthreads(); SWAIT(); SWRITE(0, SE);
    RESC(alB); __syncthreads();
    SBAR(); qkt(pA0, pA1, K_lds, qr, r32, hi);
    finishSM(pB0, pB1, alB, l_reg, pa0, pa1, pa2, pa3); SBAR();
    if (SDEPTH == 1 || j + 3 < NT) SLOAD(SE, (j + 1 + SDEPTH) * KVBLK); SBAR();
    pv_d0(o, vb0 + (int)SHM_V, pa0, pa1, pa2, pa3); partialSM(pA0, pA1, m_reg, mnA, alA);
    __syncthreads(); SWAIT(); SWRITE(1, SO);
    RESC(alA); __syncthreads();
  }
  SBAR(); qkt(pB0, pB1, (bf16*)((char*)K_lds + SHM_K), qr, r32, hi);
  finishSM(pA0, pA1, alA, l_reg, pa0, pa1, pa2, pa3); SBAR();
  pv_d0(o, vb0, pa0, pa1, pa2, pa3); partialSM(pB0, pB1, m_reg, mnB, alB);
  __syncthreads(); RESC(alB);
  finishSM(pB0, pB1, alB, l_reg, pa0, pa1, pa2, pa3); SBAR();
  pv_d0(o, vb0 + (int)SHM_V, pa0, pa1, pa2, pa3);
  if (hi == 0) li_l[r32] = l_reg; asm volatile("s_waitcnt lgkmcnt(0)" ::: "memory");
  float rli[16];
#pragma unroll
  for (int r = 0; r < 16; ++r) rli[r] = __builtin_amdgcn_rcpf(li_l[crow(r, hi)]);
  float* Ow = Ob + (long)(wid * QBLK) * LDO;
#pragma unroll
  for (int r = 0; r < 16; ++r) { int orow = crow(r, hi);
    for (int d0 = 0; d0 < 4; ++d0) { float* op = &Ow[(long)orow * LDO + d0 * 32 + r32];
      if (MODE == 0) *op = o[d0][r] * rli[r]; else *op = *op - lam * (o[d0][r] * rli[r]); } }
  asm volatile("s_waitcnt vmcnt(0)" ::: "memory"); __syncthreads();
#undef SLOAD
#undef SWRITE
#undef SWAIT
#undef RESC
}
__device__ __forceinline__ bf16x8 pk8(const f32x16& P, int base) {
  unsigned a0 = cvtpk(P[base + 0], P[base + 1]), a1 = cvtpk(P[base + 2], P[base + 3]);
  unsigned b0 = cvtpk(P[base + 4], P[base + 5]), b1 = cvtpk(P[base + 6], P[base + 7]);
  auto r0 = __builtin_amdgcn_permlane32_swap(a0, b0, false, false); auto r1 = __builtin_amdgcn_permlane32_swap(a1, b1, false, false);
  u32x4 w = {r0[0], r1[0], r0[1], r1[1]}; return *reinterpret_cast<bf16x8*>(&w);
}
template <int DA, int DB> __device__ __forceinline__ void pv_pair(f32x16& oa, f32x16& ob, int vbase, bf16x8 f0, bf16x8 f1) {
  const s16x4 al0 = tr_read<v_rd_off(DA, 0, 0)>(vbase), ah0 = tr_read<v_rd_off(DA, 0, 1)>(vbase), al1 = tr_read<v_rd_off(DA, 1, 0)>(vbase), ah1 = tr_read<v_rd_off(DA, 1, 1)>(vbase);
  const s16x4 bl0 = tr_read<v_rd_off(DB, 0, 0)>(vbase), bh0 = tr_read<v_rd_off(DB, 0, 1)>(vbase), bl1 = tr_read<v_rd_off(DB, 1, 0)>(vbase), bh1 = tr_read<v_rd_off(DB, 1, 1)>(vbase);
  asm volatile("s_waitcnt lgkmcnt(0)" ::: "memory"); SBAR();
#define PK(L, H) (bf16x8){L[0], L[1], L[2], L[3], H[0], H[1], H[2], H[3]}
  __builtin_amdgcn_s_setprio(1);
  oa = __builtin_amdgcn_mfma_f32_32x32x16_bf16(f0, PK(al0, ah0), oa, 0, 0, 0);
  ob = __builtin_amdgcn_mfma_f32_32x32x16_bf16(f0, PK(bl0, bh0), ob, 0, 0, 0);
  oa = __builtin_amdgcn_mfma_f32_32x32x16_bf16(f1, PK(al1, ah1), oa, 0, 0, 0);
  ob = __builtin_amdgcn_mfma_f32_32x32x16_bf16(f1, PK(bl1, bh1), ob, 0, 0, 0);
  __builtin_amdgcn_s_setprio(0);
#undef PK
}
template <int DA, int DB> __device__ __forceinline__ void pv_pair_np(f32x16& oa, f32x16& ob, int vbase, bf16x8 f0, bf16x8 f1) {
  const s16x4 al0 = tr_read<v_rd_off(DA, 0, 0)>(vbase), ah0 = tr_read<v_rd_off(DA, 0, 1)>(vbase), al1 = tr_read<v_rd_off(DA, 1, 0)>(vbase), ah1 = tr_read<v_rd_off(DA, 1, 1)>(vbase);
  const s16x4 bl0 = tr_read<v_rd_off(DB, 0, 0)>(vbase), bh0 = tr_read<v_rd_off(DB, 0, 1)>(vbase), bl1 = tr_read<v_rd_off(DB, 1, 0)>(vbase), bh1 = tr_read<v_rd_off(DB, 1, 1)>(vbase);
  asm volatile("s_waitcnt lgkmcnt(0)" ::: "memory"); SBAR();
#define PK(L, H) (bf16x8){L[0], L[1], L[2], L[3], H[0], H[1], H[2], H[3]}
  oa = __builtin_amdgcn_mfma_f32_32x32x16_bf16(f0, PK(al0, ah0), oa, 0, 0, 0);
  ob = __builtin_amdgcn_mfma_f32_32x32x16_bf16(f0, PK(bl0, bh0), ob, 0, 0, 0);
  oa = __builtin_amdgcn_mfma_f32_32x32x16_bf16(f1, PK(al1, ah1), oa, 0, 0, 0);
  ob = __builtin_amdgcn_mfma_f32_32x32x16_bf16(f1, PK(bl1, bh1), ob, 0, 0, 0);
#undef PK
}
template <int DA, int DB> __device__ __forceinline__ void pv_pair_cw(f32x16& oa, f32x16& ob, int vbase, bf16x8 f0, bf16x8 f1) {
  const s16x4 al0 = tr_read<v_rd_off(DA, 0, 0)>(vbase), ah0 = tr_read<v_rd_off(DA, 0, 1)>(vbase), bl0 = tr_read<v_rd_off(DB, 0, 0)>(vbase), bh0 = tr_read<v_rd_off(DB, 0, 1)>(vbase);
  const s16x4 al1 = tr_read<v_rd_off(DA, 1, 0)>(vbase), ah1 = tr_read<v_rd_off(DA, 1, 1)>(vbase), bl1 = tr_read<v_rd_off(DB, 1, 0)>(vbase), bh1 = tr_read<v_rd_off(DB, 1, 1)>(vbase);
  asm volatile("s_waitcnt lgkmcnt(4)" ::: "memory"); SBAR();
#define PK(L, H) (bf16x8){L[0], L[1], L[2], L[3], H[0], H[1], H[2], H[3]}
  oa = __builtin_amdgcn_mfma_f32_32x32x16_bf16(f0, PK(al0, ah0), oa, 0, 0, 0);
  ob = __builtin_amdgcn_mfma_f32_32x32x16_bf16(f0, PK(bl0, bh0), ob, 0, 0, 0);
  SBAR(); asm volatile("s_waitcnt lgkmcnt(0)" ::: "memory"); SBAR();
  oa = __builtin_amdgcn_mfma_f32_32x32x16_bf16(f1, PK(al1, ah1), oa, 0, 0, 0);
  ob = __builtin_amdgcn_mfma_f32_32x32x16_bf16(f1, PK(bl1, bh1), ob, 0, 0, 0);
#undef PK
}
#define PVR(S, DA, DB, vbase) do { S[0] = tr_read<v_rd_off(DA, 0, 0)>(vbase); S[1] = tr_read<v_rd_off(DA, 0, 1)>(vbase); S[2] = tr_read<v_rd_off(DB, 0, 0)>(vbase); S[3] = tr_read<v_rd_off(DB, 0, 1)>(vbase); \
    S[4] = tr_read<v_rd_off(DA, 1, 0)>(vbase); S[5] = tr_read<v_rd_off(DA, 1, 1)>(vbase); S[6] = tr_read<v_rd_off(DB, 1, 0)>(vbase); S[7] = tr_read<v_rd_off(DB, 1, 1)>(vbase); } while (0)
#define PVK(L, H) (bf16x8){L[0], L[1], L[2], L[3], H[0], H[1], H[2], H[3]}
#define PVM(S, OA, OB, F0, F1) do { OA = __builtin_amdgcn_mfma_f32_32x32x16_bf16(F0, PVK(S[0], S[1]), OA, 0, 0, 0); OB = __builtin_amdgcn_mfma_f32_32x32x16_bf16(F0, PVK(S[2], S[3]), OB, 0, 0, 0); \
    OA = __builtin_amdgcn_mfma_f32_32x32x16_bf16(F1, PVK(S[4], S[5]), OA, 0, 0, 0); OB = __builtin_amdgcn_mfma_f32_32x32x16_bf16(F1, PVK(S[6], S[7]), OB, 0, 0, 0); } while (0)
#define PV_CHAIN4(O, v0, v1, F0, F1) do { s16x4 R0_[8], R1_[8]; \
    PVR(R0_, 0, 1, v0); PVR(R1_, 2, 3, v0); asm volatile("s_waitcnt lgkmcnt(8)" ::: "memory"); SBAR(); PVM(R0_, O[0], O[1], F0, F1); SBAR(); \
    PVR(R0_, 0, 1, v1); asm volatile("s_waitcnt lgkmcnt(8)" ::: "memory"); SBAR(); PVM(R1_, O[2], O[3], F0, F1); SBAR(); \
    PVR(R1_, 2, 3, v1); asm volatile("s_waitcnt lgkmcnt(8)" ::: "memory"); SBAR(); PVM(R0_, O[4], O[5], F0, F1); SBAR(); \
    asm volatile("s_waitcnt lgkmcnt(0)" ::: "memory"); SBAR(); PVM(R1_, O[6], O[7], F0, F1); } while (0)
#define PV_TAIL4(O, v0, v1, F0, F1) do { \
    PVR(R1_, 2, 3, v0); asm volatile("s_waitcnt lgkmcnt(8)" ::: "memory"); SBAR(); PVM(R0_, O[0], O[1], F0, F1); SBAR(); \
    PVR(R0_, 0, 1, v1); asm volatile("s_waitcnt lgkmcnt(8)" ::: "memory"); SBAR(); PVM(R1_, O[2], O[3], F0, F1); SBAR(); \
    PVR(R1_, 2, 3, v1); asm volatile("s_waitcnt lgkmcnt(8)" ::: "memory"); SBAR(); PVM(R0_, O[4], O[5], F0, F1); SBAR(); \
    asm volatile("s_waitcnt lgkmcnt(0)" ::: "memory"); SBAR(); PVM(R1_, O[6], O[7], F0, F1); } while (0)
constexpr int PAIR_LDS = 116736;
template <int MODE>
__device__ __forceinline__ void attn_pair_body(const bf16* __restrict__ Qb, const bf16* __restrict__ Kh, const bf16* __restrict__ Vh, float* Ob, int seq, char* lds, float lam, float negMc) {
  using St = Stage<bf16>;
  int tid_ = threadIdx.x; asm volatile("" : "+v"(tid_));
  const int tid = tid_, wid = tid >> 6, lane = tid & 63, r32 = lane & 31, hi = lane >> 5, g = wid >> 1, kh = wid & 1;
  char* K_lds = lds; char* V_lds = lds + 32768; char* X_lds = lds + 98304; float* L_lds = (float*)(lds + 114688);
  constexpr float C = SCALE * 1.4426950408889634f;
  f32x16 o[4] = {}; bf16x8 qr[8]; float lsum = 0.f;
  const bf16* Qw = Qb + (long)(g * 32 + r32) * LDQ + hi * 8;
#pragma unroll
  for (int d0 = 0; d0 < 8; ++d0) qr[d0] = St::ld8(Qw + d0 * 16);
  const int sr = tid >> 4, sc = (tid & 15) * 8, vst0 = v_st(sr, sc), vst1 = v_st(32 + sr, sc);
  const int vb = (int)(uintptr_t)V_lds + kh * 16384 + v_rd_base(lane);
  const int vbA = vb + 2 * kh * 4096, vbB = vb + 2 * (1 - kh) * 4096;
  const int krow = 32 * kh + r32;
  char* xw = X_lds + (wid * 64 + lane) * 32; const char* xr = X_lds + ((wid ^ 1) * 64 + lane) * 32;
  bf16x8 sk0, sk1, sv0, sv1, sv2, sv3;
#define PLOAD(k0) do { sk0 = St::ld8(&Kh[(long)((k0) + sr) * LDK + sc]); sk1 = St::ld8(&Kh[(long)((k0) + 32 + sr) * LDK + sc]); \
    sv0 = St::ld8(&Vh[(long)((k0) + sr) * LDK + sc]); sv1 = St::ld8(&Vh[(long)((k0) + 32 + sr) * LDK + sc]); \
    sv2 = St::ld8(&Vh[(long)((k0) + sr) * LDK + 128 + sc]); sv3 = St::ld8(&Vh[(long)((k0) + 32 + sr) * LDK + 128 + sc]); } while (0)
#define PWRITE(b) do { *(bf16x8*)(K_lds + (b) * 16384 + KSWZ(sr, sc * 2)) = sk0; *(bf16x8*)(K_lds + (b) * 16384 + KSWZ(32 + sr, sc * 2)) = sk1; \
    *(bf16x8*)(V_lds + (b) * 32768 + vst0) = sv0; *(bf16x8*)(V_lds + (b) * 32768 + vst1) = sv1; \
    *(bf16x8*)(V_lds + (b) * 32768 + 16384 + vst0) = sv2; *(bf16x8*)(V_lds + (b) * 32768 + 16384 + vst1) = sv3; } while (0)
  const int NT = seq / KVBLK;
  PLOAD(0); PWRITE(0); PLOAD(KVBLK); __syncthreads();
  for (int j = 0; j < NT; ++j) {
    const int buf = j & 1;
    const char* Kb = K_lds + buf * 16384;
    f32x16 pe = {}, po = {};
#pragma unroll
    for (int d0 = 0; d0 < 8; d0 += 2) {
      const bf16x8 k0 = *reinterpret_cast<const bf16x8*>(Kb + KSWZ(krow, (d0 * 16 + hi * 8) * 2));
      const bf16x8 k1 = *reinterpret_cast<const bf16x8*>(Kb + KSWZ(krow, ((d0 + 1) * 16 + hi * 8) * 2));
      pe = __builtin_amdgcn_mfma_f32_32x32x16_bf16(k0, qr[d0], pe, 0, 0, 0);
      po = __builtin_amdgcn_mfma_f32_32x32x16_bf16(k1, qr[d0 + 1], po, 0, 0, 0); }
    f32x16 p;
#pragma unroll
    for (int r = 0; r < 16; ++r) p[r] = __builtin_amdgcn_exp2f(fmaf(pe[r] + po[r], C, negMc));
    float ps = 0.f;
#pragma unroll
    for (int r = 0; r < 16; ++r) ps += p[r];
    lsum += ps;
    const bf16x8 own0 = pk8(p, 0), own1 = pk8(p, 8);
    *(bf16x8*)(xw) = own0; *(bf16x8*)(xw + 16) = own1;
    const int vo = buf * 32768;
    SBAR();
    pv_pair<0, 1>(o[0], o[1], vbA + vo, own0, own1); pv_pair<2, 3>(o[2], o[3], vbA + vo, own0, own1);
    __syncthreads();
    const bf16x8 pt0 = *(const bf16x8*)(xr), pt1 = *(const bf16x8*)(xr + 16);
    if (j + 1 < NT) { PWRITE(buf ^ 1); }
    if (j + 2 < NT) { PLOAD((j + 2) * KVBLK); }
    SBAR();
    pv_pair<0, 1>(o[0], o[1], vbB + vo, pt0, pt1); pv_pair<2, 3>(o[2], o[3], vbB + vo, pt0, pt1);
    __syncthreads();
  }
  L_lds[(wid * 2 + hi) * 32 + r32] = lsum;
  __syncthreads();
  float rli[16];
#pragma unroll
  for (int r = 0; r < 16; ++r) { const int row = crow(r, hi); const float* lp = L_lds + (g * 4) * 32 + row; rli[r] = __builtin_amdgcn_rcpf((lp[0] + lp[32]) + (lp[64] + lp[96])); }
  float* Ow = Ob + (long)(g * 32) * LDO + kh * 128;
#pragma unroll
  for (int r = 0; r < 16; ++r) { const int orow = crow(r, hi);
    for (int d0 = 0; d0 < 4; ++d0) { float* op = &Ow[(long)orow * LDO + d0 * 32 + r32];
      if (MODE == 0) *op = o[d0][r] * rli[r]; else *op = *op - lam * (o[d0][r] * rli[r]); } }
  asm volatile("s_waitcnt vmcnt(0)" ::: "memory"); __syncthreads();
#undef PLOAD
#undef PWRITE
}
template <int MODE>
__device__ __forceinline__ void attn_stag_body(const bf16* __restrict__ Qb, const bf16* __restrict__ Kh, const bf16* __restrict__ Vh, float* Ob, int seq, char* lds, float lam, float negMc) {
  using St = Stage<bf16>;
  int tid_ = threadIdx.x; asm volatile("" : "+v"(tid_));
  const int tid = tid_, wid = tid >> 6, lane = tid & 63, r32 = lane & 31, hi = lane >> 5, g = wid >> 1, kh = wid & 1;
  const bool early = wid < 4;
  char* K_lds = lds; char* V_lds = lds + 32768; char* X_lds = lds + 98304; float* L_lds = (float*)(lds + 114688);
  constexpr float C = SCALE * 1.4426950408889634f;
  f32x16 o[4] = {}; bf16x8 qr[8]; float lsum = 0.f;
  const bf16* Qw = Qb + (long)(g * 32 + r32) * LDQ + hi * 8;
#pragma unroll
  for (int d0 = 0; d0 < 8; ++d0) qr[d0] = St::ld8(Qw + d0 * 16);
  const int vb = (int)(uintptr_t)V_lds + kh * 16384 + v_rd_base(lane);
  const int vbA = vb + 2 * kh * 4096, vbB = vb + 2 * (1 - kh) * 4096;
  const int krow = 32 * kh + r32;
  char* xw = X_lds + (wid * 64 + lane) * 32; const char* xr = X_lds + ((wid ^ 1) * 64 + lane) * 32;
  const int NT = seq / KVBLK;
  { const int sr = tid >> 4, sc = (tid & 15) * 8;
    const bf16x8 a0 = St::ld8(&Kh[(long)(sr) * LDK + sc]), a1 = St::ld8(&Kh[(long)(32 + sr) * LDK + sc]);
    const bf16x8 b0 = St::ld8(&Vh[(long)(sr) * LDK + sc]), b1 = St::ld8(&Vh[(long)(32 + sr) * LDK + sc]), b2 = St::ld8(&Vh[(long)(sr) * LDK + 128 + sc]), b3 = St::ld8(&Vh[(long)(32 + sr) * LDK + 128 + sc]);
    const bf16x8 c0 = St::ld8(&Kh[(long)(64 + sr) * LDK + sc]), c1 = St::ld8(&Kh[(long)(96 + sr) * LDK + sc]);
    *(bf16x8*)(K_lds + KSWZ(sr, sc * 2)) = a0; *(bf16x8*)(K_lds + KSWZ(32 + sr, sc * 2)) = a1;
    *(bf16x8*)(V_lds + v_st(sr, sc)) = b0; *(bf16x8*)(V_lds + v_st(32 + sr, sc)) = b1; *(bf16x8*)(V_lds + 16384 + v_st(sr, sc)) = b2; *(bf16x8*)(V_lds + 16384 + v_st(32 + sr, sc)) = b3;
    *(bf16x8*)(K_lds + 16384 + KSWZ(sr, sc * 2)) = c0; *(bf16x8*)(K_lds + 16384 + KSWZ(32 + sr, sc * 2)) = c1; }
  const int th = tid & 255, sr = th >> 4, sc = (th & 15) * 8;
  bf16x8 st[8];
#define LOADV(k0) do { _Pragma("unroll") for (int q = 0; q < 4; ++q) { st[q] = St::ld8(&Vh[(long)((k0) + sr + 16 * q) * LDK + sc]); st[4 + q] = St::ld8(&Vh[(long)((k0) + sr + 16 * q) * LDK + 128 + sc]); } } while (0)
#define WRITEV(b) do { _Pragma("unroll") for (int q = 0; q < 4; ++q) { *(bf16x8*)(V_lds + (b) * 32768 + v_st(sr + 16 * q, sc)) = st[q]; *(bf16x8*)(V_lds + (b) * 32768 + 16384 + v_st(sr + 16 * q, sc)) = st[4 + q]; } } while (0)
#define LOADK(k0) do { _Pragma("unroll") for (int q = 0; q < 4; ++q) st[q] = St::ld8(&Kh[(long)((k0) + sr + 16 * q) * LDK + sc]); } while (0)
#define WRITEK(b) do { _Pragma("unroll") for (int q = 0; q < 4; ++q) *(bf16x8*)(K_lds + (b) * 16384 + KSWZ(sr + 16 * q, sc * 2)) = st[q]; } while (0)
  if (early) { LOADV(KVBLK); } else { LOADK(2 * KVBLK); }
  __syncthreads();
  if (!early) __syncthreads();
  for (int j = 0; j < NT; ++j) {
    const int buf = j & 1;
    const char* Kb = K_lds + buf * 16384;
    f32x16 pe = {}, po = {};
    __builtin_amdgcn_s_setprio(1);
#pragma unroll
    for (int d0 = 0; d0 < 8; d0 += 2) {
      const bf16x8 k0 = *reinterpret_cast<const bf16x8*>(Kb + KSWZ(krow, (d0 * 16 + hi * 8) * 2));
      const bf16x8 k1 = *reinterpret_cast<const bf16x8*>(Kb + KSWZ(krow, ((d0 + 1) * 16 + hi * 8) * 2));
      pe = __builtin_amdgcn_mfma_f32_32x32x16_bf16(k0, qr[d0], pe, 0, 0, 0);
      po = __builtin_amdgcn_mfma_f32_32x32x16_bf16(k1, qr[d0 + 1], po, 0, 0, 0); }
    __builtin_amdgcn_s_setprio(0);
    f32x16 p;
#pragma unroll
    for (int r = 0; r < 16; ++r) p[r] = __builtin_amdgcn_exp2f(fmaf(pe[r] + po[r], C, negMc));
    float ps = 0.f;
#pragma unroll
    for (int r = 0; r < 16; ++r) ps += p[r];
    lsum += ps;
    const bf16x8 own0 = pk8(p, 0), own1 = pk8(p, 8);
    *(bf16x8*)(xw) = own0; *(bf16x8*)(xw + 16) = own1;
    __syncthreads();
    const bf16x8 pt0 = *(const bf16x8*)(xr), pt1 = *(const bf16x8*)(xr + 16);
    if (early) { if (j + 1 < NT) { WRITEV(buf ^ 1); } if (j + 2 < NT) { LOADV((j + 2) * KVBLK); } }
    else       { if (j + 2 < NT) { WRITEK(buf); }     if (j + 3 < NT) { LOADK((j + 3) * KVBLK); } }
    const int vo = buf * 32768;
    SBAR();
    pv_pair<0, 1>(o[0], o[1], vbA + vo, own0, own1); pv_pair<2, 3>(o[2], o[3], vbA + vo, own0, own1);
    pv_pair<0, 1>(o[0], o[1], vbB + vo, pt0, pt1); pv_pair<2, 3>(o[2], o[3], vbB + vo, pt0, pt1);
    __syncthreads();
  }
  if (early) __syncthreads();
  L_lds[(wid * 2 + hi) * 32 + r32] = lsum;
  __syncthreads();
  float rli[16];
#pragma unroll
  for (int r = 0; r < 16; ++r) { const int row = crow(r, hi); const float* lp = L_lds + (g * 4) * 32 + row; rli[r] = __builtin_amdgcn_rcpf((lp[0] + lp[32]) + (lp[64] + lp[96])); }
  float* Ow = Ob + (long)(g * 32) * LDO + kh * 128;
#pragma unroll
  for (int r = 0; r < 16; ++r) { const int orow = crow(r, hi);
    for (int d0 = 0; d0 < 4; ++d0) { float* op = &Ow[(long)orow * LDO + d0 * 32 + r32];
      if (MODE == 0) *op = o[d0][r] * rli[r]; else *op = *op - lam * (o[d0][r] * rli[r]); } }
  asm volatile("s_waitcnt vmcnt(0)" ::: "memory"); __syncthreads();
#undef LOADV
#undef WRITEV
#undef LOADK
#undef WRITEK
}
template <int MODE>
__device__ __forceinline__ void attn_pair4_body(const bf16* __restrict__ Qb, const bf16* __restrict__ Kh, const bf16* __restrict__ Vh, float* Ob, int seq, char* lds, float lam, float negMc) {
  using St = Stage<bf16>;
  int tid_ = threadIdx.x; asm volatile("" : "+v"(tid_));
  const int tid = tid_, wid = tid >> 6, lane = tid & 63, r32 = lane & 31, hi = lane >> 5, g = wid >> 1, kh = wid & 1;
  char* K_lds = lds; char* V_lds = lds + 32768; char* X_lds = lds + 98304; float* L_lds = (float*)(lds + 114688);
  constexpr float C = SCALE * 1.4426950408889634f;
  f32x16 o[4] = {}; bf16x8 qr[8]; float lsum = 0.f;
  const bf16* Qw = Qb + (long)(g * 32 + r32) * 128 + hi * 8;
#pragma unroll
  for (int d0 = 0; d0 < 8; ++d0) qr[d0] = St::ld8(Qw + d0 * 16);
  const int sr = tid >> 4, sc = (tid & 15) * 8, vst0 = v_st(sr, sc), vst1 = v_st(32 + sr, sc);
  const int vb = (int)(uintptr_t)V_lds + kh * 16384 + v_rd_base(lane);
  const int vbA = vb + 2 * kh * 4096, vbB = vb + 2 * (1 - kh) * 4096;
  const int krow = 32 * kh + r32;
  char* xw = X_lds + (wid * 64 + lane) * 32; const char* xr = X_lds + ((wid ^ 1) * 64 + lane) * 32;
  bf16x8 sk0, sk1, sv0, sv1, sv2, sv3;
#define PLOAD(k0) do { sk0 = St::ld8(&Kh[(long)((k0) + sr) * 128 + sc]); sk1 = St::ld8(&Kh[(long)((k0) + 32 + sr) * 128 + sc]); \
    sv0 = St::ld8(&Vh[(long)((k0) + sr) * 256 + sc]); sv1 = St::ld8(&Vh[(long)((k0) + 32 + sr) * 256 + sc]); \
    sv2 = St::ld8(&Vh[(long)((k0) + sr) * 256 + 128 + sc]); sv3 = St::ld8(&Vh[(long)((k0) + 32 + sr) * 256 + 128 + sc]); } while (0)
#define PWRITE(b) do { *(bf16x8*)(K_lds + (b) * 16384 + KSWZ(sr, sc * 2)) = sk0; *(bf16x8*)(K_lds + (b) * 16384 + KSWZ(32 + sr, sc * 2)) = sk1; \
    *(bf16x8*)(V_lds + (b) * 32768 + vst0) = sv0; *(bf16x8*)(V_lds + (b) * 32768 + vst1) = sv1; \
    *(bf16x8*)(V_lds + (b) * 32768 + 16384 + vst0) = sv2; *(bf16x8*)(V_lds + (b) * 32768 + 16384 + vst1) = sv3; } while (0)
  const int NT = seq / KVBLK;
  PLOAD(0); PWRITE(0); PLOAD(KVBLK); __syncthreads();
  for (int j = 0; j < NT; ++j) {
    const int buf = j & 1;
    const char* Kb = K_lds + buf * 16384;
    f32x16 pe = {}, po = {};
#pragma unroll
    for (int d0 = 0; d0 < 8; d0 += 2) {
      const bf16x8 k0 = *reinterpret_cast<const bf16x8*>(Kb + KSWZ(krow, (d0 * 16 + hi * 8) * 2));
      const bf16x8 k1 = *reinterpret_cast<const bf16x8*>(Kb + KSWZ(krow, ((d0 + 1) * 16 + hi * 8) * 2));
      pe = __builtin_amdgcn_mfma_f32_32x32x16_bf16(k0, qr[d0], pe, 0, 0, 0);
      po = __builtin_amdgcn_mfma_f32_32x32x16_bf16(k1, qr[d0 + 1], po, 0, 0, 0); }
    f32x16 p;
#pragma unroll
    for (int r = 0; r < 16; ++r) p[r] = __builtin_amdgcn_exp2f(fmaf(pe[r] + po[r], C, negMc));
    float ps = 0.f;
#pragma unroll
    for (int r = 0; r < 16; ++r) ps += p[r];
    lsum += ps;
    const bf16x8 own0 = pk8(p, 0), own1 = pk8(p, 8);
    *(bf16x8*)(xw) = own0; *(bf16x8*)(xw + 16) = own1;
    const int vo = buf * 32768;
    SBAR();
    pv_pair<0, 1>(o[0], o[1], vbA + vo, own0, own1); pv_pair<2, 3>(o[2], o[3], vbA + vo, own0, own1);
    __syncthreads();
    const bf16x8 pt0 = *(const bf16x8*)(xr), pt1 = *(const bf16x8*)(xr + 16);
    if (j + 1 < NT) { PWRITE(buf ^ 1); }
    if (j + 2 < NT) { PLOAD((j + 2) * KVBLK); }
    SBAR();
    pv_pair<0, 1>(o[0], o[1], vbB + vo, pt0, pt1); pv_pair<2, 3>(o[2], o[3], vbB + vo, pt0, pt1);
    __syncthreads();
  }
  L_lds[(wid * 2 + hi) * 32 + r32] = lsum;
  __syncthreads();
  float rli[16];
#pragma unroll
  for (int r = 0; r < 16; ++r) { const int row = crow(r, hi); const float* lp = L_lds + (g * 4) * 32 + row; rli[r] = __builtin_amdgcn_rcpf((lp[0] + lp[32]) + (lp[64] + lp[96])); }
  float* Ow = Ob + (long)(g * 32) * LDO + kh * 128;
#pragma unroll
  for (int r = 0; r < 16; ++r) { const int orow = crow(r, hi);
    for (int d0 = 0; d0 < 4; ++d0) { float* op = &Ow[(long)orow * LDO + d0 * 32 + r32];
      if (MODE == 0) *op = o[d0][r] * rli[r]; else *op = *op - lam * (o[d0][r] * rli[r]); } }
  asm volatile("s_waitcnt vmcnt(0)" ::: "memory"); __syncthreads();
#undef PLOAD
#undef PWRITE
}
template <int MODE>
__device__ __forceinline__ void attn_pair5_body(const bf16* __restrict__ Qb, const bf16* __restrict__ Kh, const bf16* __restrict__ Vh, float* Ob, int seq, char* lds, float lam, float negMc) {
  using St = Stage<bf16>;
  int tid_ = threadIdx.x; asm volatile("" : "+v"(tid_));
  const int tid = tid_, wid = tid >> 6, lane = tid & 63, r32 = lane & 31, hi = lane >> 5, g = wid >> 1, kh = wid & 1;
  char* K_lds = lds; char* V_lds = lds + 32768; char* X_lds = lds + 98304; float* L_lds = (float*)(lds + 114688);
  constexpr float C = SCALE * 1.4426950408889634f;
  f32x16 o[4] = {}; bf16x8 qr[8]; float lsum = 0.f;
  const bf16* Qw = Qb + (long)(g * 32 + r32) * 128 + hi * 8;
#pragma unroll
  for (int d0 = 0; d0 < 8; ++d0) qr[d0] = St::ld8(Qw + d0 * 16);
  const int sr = tid >> 4, sc = (tid & 15) * 8, vst0 = v_st(sr, sc), vst1 = v_st(32 + sr, sc);
  const int vb = (int)(uintptr_t)V_lds + kh * 16384 + v_rd_base(lane);
  const int vbA = vb + 2 * kh * 4096, vbB = vb + 2 * (1 - kh) * 4096;
  const int krow = 32 * kh + r32;
  char* xw = X_lds + (wid * 64 + lane) * 32; const char* xr = X_lds + ((wid ^ 1) * 64 + lane) * 32;
  bf16x8 sk0, sk1, sv0, sv1, sv2, sv3;
#define KLOAD(k0) do { sk0 = St::ld8(&Kh[(long)((k0) + sr) * 128 + sc]); sk1 = St::ld8(&Kh[(long)((k0) + 32 + sr) * 128 + sc]); } while (0)
#define VLOAD(k0) do { sv0 = St::ld8(&Vh[(long)((k0) + sr) * 256 + sc]); sv1 = St::ld8(&Vh[(long)((k0) + 32 + sr) * 256 + sc]); \
    sv2 = St::ld8(&Vh[(long)((k0) + sr) * 256 + 128 + sc]); sv3 = St::ld8(&Vh[(long)((k0) + 32 + sr) * 256 + 128 + sc]); } while (0)
#define KWRITE(b) do { *(bf16x8*)(K_lds + (b) * 16384 + KSWZ(sr, sc * 2)) = sk0; *(bf16x8*)(K_lds + (b) * 16384 + KSWZ(32 + sr, sc * 2)) = sk1; } while (0)
#define VWRITE(b) do { *(bf16x8*)(V_lds + (b) * 32768 + vst0) = sv0; *(bf16x8*)(V_lds + (b) * 32768 + vst1) = sv1; \
    *(bf16x8*)(V_lds + (b) * 32768 + 16384 + vst0) = sv2; *(bf16x8*)(V_lds + (b) * 32768 + 16384 + vst1) = sv3; } while (0)
#define QKT(PE, PO, b) do { const char* Kb_ = K_lds + (b) * 16384; PE = f32x16{}; PO = f32x16{}; \
    _Pragma("unroll") for (int d0 = 0; d0 < 8; d0 += 2) { \
      const bf16x8 k0_ = *reinterpret_cast<const bf16x8*>(Kb_ + KSWZ(krow, (d0 * 16 + hi * 8) * 2)); \
      const bf16x8 k1_ = *reinterpret_cast<const bf16x8*>(Kb_ + KSWZ(krow, ((d0 + 1) * 16 + hi * 8) * 2)); \
      PE = __builtin_amdgcn_mfma_f32_32x32x16_bf16(k0_, qr[d0], PE, 0, 0, 0); \
      PO = __builtin_amdgcn_mfma_f32_32x32x16_bf16(k1_, qr[d0 + 1], PO, 0, 0, 0); } } while (0)
  const int NT = seq / KVBLK;
  KLOAD(0); VLOAD(0); KWRITE(0); VWRITE(0); KLOAD(KVBLK); KWRITE(1); KLOAD(2 * KVBLK); VLOAD(KVBLK); __syncthreads();
  f32x16 pe, po, pc;
  QKT(pe, po, 0);
#pragma unroll
  for (int r = 0; r < 16; ++r) pc[r] = pe[r] + po[r];
  for (int j = 0; j < NT; ++j) {
    const int buf = j & 1;
    SBAR();
    if (j + 1 < NT) { QKT(pe, po, buf ^ 1); }
    f32x16 p;
#pragma unroll
    for (int r = 0; r < 16; ++r) p[r] = __builtin_amdgcn_exp2f(fmaf(pc[r], C, negMc));
    float ps = 0.f;
#pragma unroll
    for (int r = 0; r < 16; ++r) ps += p[r];
    lsum += ps;
    const bf16x8 own0 = pk8(p, 0), own1 = pk8(p, 8);
    *(bf16x8*)(xw) = own0; *(bf16x8*)(xw + 16) = own1;
    const int vo = buf * 32768;
#pragma unroll
    for (int q_ = 0; q_ < 8; ++q_) { __builtin_amdgcn_sched_group_barrier(0x100, 1, 0); __builtin_amdgcn_sched_group_barrier(0x008, 1, 0); __builtin_amdgcn_sched_group_barrier(0x002, 9, 0); }
    SBAR();
    pv_pair<0, 1>(o[0], o[1], vbA + vo, own0, own1); pv_pair<2, 3>(o[2], o[3], vbA + vo, own0, own1);
    __syncthreads();
    const bf16x8 pt0 = *(const bf16x8*)(xr), pt1 = *(const bf16x8*)(xr + 16);
    if (j + 2 < NT) { KWRITE(buf); }
    if (j + 1 < NT) { VWRITE(buf ^ 1); }
    if (j + 3 < NT) { KLOAD((j + 3) * KVBLK); }
    if (j + 2 < NT) { VLOAD((j + 2) * KVBLK); }
    SBAR();
    pv_pair<0, 1>(o[0], o[1], vbB + vo, pt0, pt1); pv_pair<2, 3>(o[2], o[3], vbB + vo, pt0, pt1);
#pragma unroll
    for (int r = 0; r < 16; ++r) pc[r] = pe[r] + po[r];
    __syncthreads();
  }
#undef KLOAD
#undef VLOAD
#undef KWRITE
#undef VWRITE
#undef QKT
  L_lds[(wid * 2 + hi) * 32 + r32] = lsum;
  __syncthreads();
  float rli[16];
#pragma unroll
  for (int r = 0; r < 16; ++r) { const int row = crow(r, hi); const float* lp = L_lds + (g * 4) * 32 + row; rli[r] = __builtin_amdgcn_rcpf((lp[0] + lp[32]) + (lp[64] + lp[96])); }
  float* Ow = Ob + (long)(g * 32) * LDO + kh * 128;
#pragma unroll
  for (int r = 0; r < 16; ++r) { const int orow = crow(r, hi);
    for (int d0 = 0; d0 < 4; ++d0) { float* op = &Ow[(long)orow * LDO + d0 * 32 + r32];
      if (MODE == 0) *op = o[d0][r] * rli[r]; else *op = *op - lam * (o[d0][r] * rli[r]); } }
  asm volatile("s_waitcnt vmcnt(0)" ::: "memory"); __syncthreads();
}
template <int MODE>
__device__ __forceinline__ void attn_pair6_body(const bf16* __restrict__ Qb, const bf16* __restrict__ Kh, const bf16* __restrict__ Vh, float* Ob, int seq, char* lds, float lam, float negMc) {
  using St = Stage<bf16>;
  int tid_ = threadIdx.x; asm volatile("" : "+v"(tid_));
  const int tid = tid_, wid = tid >> 6, lane = tid & 63, r32 = lane & 31, hi = lane >> 5, g = wid >> 1, kh = wid & 1;
  char* K_lds = lds; char* V_lds = lds + 32768; char* X_lds = lds + 98304; float* L_lds = (float*)(lds + 114688);
  constexpr float C = SCALE * 1.4426950408889634f;
  f32x16 o[4] = {}; bf16x8 qr[8]; float lsum = 0.f;
  const bf16* Qw = Qb + (long)(g * 32 + r32) * 128 + hi * 8;
#pragma unroll
  for (int d0 = 0; d0 < 8; ++d0) qr[d0] = St::ld8(Qw + d0 * 16);
  const int sr = tid >> 4, sc = (tid & 15) * 8, vst0 = v_st(sr, sc), vst1 = v_st(32 + sr, sc);
  const int vb = (int)(uintptr_t)V_lds + kh * 16384 + v_rd_base(lane);
  const int vbA = vb + 2 * kh * 4096, vbB = vb + 2 * (1 - kh) * 4096;
  const int krow = 32 * kh + r32;
  char* xw = X_lds + (wid * 64 + lane) * 32; const char* xr = X_lds + ((wid ^ 1) * 64 + lane) * 32;
  typedef __attribute__((address_space(3))) unsigned lds_u32;
  const int wu = __builtin_amdgcn_readfirstlane(wid);
  long gk[2], gv[2];
#pragma unroll
  for (int c = 0; c < 2; ++c) { const int q = wu + 8 * c;
    const int r = 4 * q + (lane >> 4), pch = lane & 15; gk[c] = (long)r * 128 + ((pch ^ (r & 7)) * 8);
    const int st = 2 * q + (lane >> 5), kk = (st >> 2) * 8 + ((lane >> 2) & 7), k = (kk & ~0xC) | ((kk & 4) << 1) | ((kk & 8) >> 1), cc = (st & 3) * 32 + (lane & 3) * 8;
    gv[c] = (long)k * 256 + cc; }
#define DMA16(gp, lp) __builtin_amdgcn_global_load_lds((const unsigned*)(gp), (lds_u32*)(lp), 16, 0, 0)
#define STAGE(k0, bb) do { const bf16* kt_ = Kh + (long)(k0) * 128; const bf16* vt_ = Vh + (long)(k0) * 256; \
    DMA16(kt_ + gk[0], K_lds + (bb) * 16384 + wu * 1024); DMA16(kt_ + gk[1], K_lds + (bb) * 16384 + (wu + 8) * 1024); \
    DMA16(vt_ + gv[0], V_lds + (bb) * 32768 + wu * 1024); DMA16(vt_ + gv[1], V_lds + (bb) * 32768 + (wu + 8) * 1024); \
    DMA16(vt_ + gv[0] + 128, V_lds + (bb) * 32768 + 16384 + wu * 1024); DMA16(vt_ + gv[1] + 128, V_lds + (bb) * 32768 + 16384 + (wu + 8) * 1024); } while (0)
#define RAWBAR() do { asm volatile("s_waitcnt lgkmcnt(0)" ::: "memory"); __builtin_amdgcn_s_barrier(); asm volatile("" ::: "memory"); } while (0)
  const int NT = seq / KVBLK;
  STAGE(0, 0); asm volatile("s_waitcnt vmcnt(0)" ::: "memory"); RAWBAR();
  for (int j = 0; j < NT; ++j) {
    const int buf = j & 1;
    if (j + 1 < NT) { STAGE((j + 1) * KVBLK, buf ^ 1); }
    const char* Kb = K_lds + buf * 16384;
    f32x16 pe = {}, po = {};
#pragma unroll
    for (int d0 = 0; d0 < 8; d0 += 2) {
      const bf16x8 k0 = *reinterpret_cast<const bf16x8*>(Kb + KSWZ(krow, (d0 * 16 + hi * 8) * 2));
      const bf16x8 k1 = *reinterpret_cast<const bf16x8*>(Kb + KSWZ(krow, ((d0 + 1) * 16 + hi * 8) * 2));
      pe = __builtin_amdgcn_mfma_f32_32x32x16_bf16(k0, qr[d0], pe, 0, 0, 0);
      po = __builtin_amdgcn_mfma_f32_32x32x16_bf16(k1, qr[d0 + 1], po, 0, 0, 0); }
    f32x16 p;
#pragma unroll
    for (int r = 0; r < 16; ++r) p[r] = __builtin_amdgcn_exp2f(fmaf(pe[r] + po[r], C, negMc));
    float ps = 0.f;
#pragma unroll
    for (int r = 0; r < 16; ++r) ps += p[r];
    lsum += ps;
    const bf16x8 own0 = pk8(p, 0), own1 = pk8(p, 8);
    *(bf16x8*)(xw) = own0; *(bf16x8*)(xw + 16) = own1;
    const int vo = buf * 32768;
    SBAR();
    pv_pair<0, 1>(o[0], o[1], vbA + vo, own0, own1); pv_pair<2, 3>(o[2], o[3], vbA + vo, own0, own1);
    RAWBAR();
    const bf16x8 pt0 = *(const bf16x8*)(xr), pt1 = *(const bf16x8*)(xr + 16);
    SBAR();
    pv_pair<0, 1>(o[0], o[1], vbB + vo, pt0, pt1); pv_pair<2, 3>(o[2], o[3], vbB + vo, pt0, pt1);
    asm volatile("s_waitcnt vmcnt(0)" ::: "memory");
    RAWBAR();
  }
#undef DMA16
#undef STAGE
#undef RAWBAR
  L_lds[(wid * 2 + hi) * 32 + r32] = lsum;
  __syncthreads();
  float rli[16];
#pragma unroll
  for (int r = 0; r < 16; ++r) { const int row = crow(r, hi); const float* lp = L_lds + (g * 4) * 32 + row; rli[r] = __builtin_amdgcn_rcpf((lp[0] + lp[32]) + (lp[64] + lp[96])); }
  float* Ow = Ob + (long)(g * 32) * LDO + kh * 128;
#pragma unroll
  for (int r = 0; r < 16; ++r) { const int orow = crow(r, hi);
    for (int d0 = 0; d0 < 4; ++d0) { float* op = &Ow[(long)orow * LDO + d0 * 32 + r32];
      if (MODE == 0) *op = o[d0][r] * rli[r]; else *op = *op - lam * (o[d0][r] * rli[r]); } }
  asm volatile("s_waitcnt vmcnt(0)" ::: "memory"); __syncthreads();
}
template <int MODE>
__device__ __forceinline__ void attn_pair7_body(const bf16* __restrict__ Qb, const bf16* __restrict__ Kh, const bf16* __restrict__ Vh, float* Ob, int seq, char* lds, float lam, float negMc) {
  using St = Stage<bf16>;
  int tid_ = threadIdx.x; asm volatile("" : "+v"(tid_));
  const int tid = tid_, wid = tid >> 6, lane = tid & 63, r32 = lane & 31, hi = lane >> 5, g = wid >> 1, kh = wid & 1;
  char* K_lds = lds; char* V_lds = lds + 32768; char* X_lds = lds + 98304; float* L_lds = (float*)(lds + 131072);
  constexpr float C = SCALE * 1.4426950408889634f;
  f32x16 o[4] = {}; bf16x8 qr[8]; float lsum = 0.f;
  const bf16* Qw = Qb + (long)(g * 32 + r32) * 128 + hi * 8;
#pragma unroll
  for (int d0 = 0; d0 < 8; ++d0) qr[d0] = St::ld8(Qw + d0 * 16);
  const int sr = tid >> 4, sc = (tid & 15) * 8, vst0 = v_st(sr, sc), vst1 = v_st(32 + sr, sc);
  const int vb = (int)(uintptr_t)V_lds + kh * 16384 + v_rd_base(lane);
  const int vbA = vb + 2 * kh * 4096, vbB = vb + 2 * (1 - kh) * 4096;
  const int krow = 32 * kh + r32;
  char* xw = X_lds + (wid * 64 + lane) * 32; const char* xr = X_lds + ((wid ^ 1) * 64 + lane) * 32;
  typedef __attribute__((address_space(3))) unsigned lds_u32;
  const int wu = __builtin_amdgcn_readfirstlane(wid);
  long gk[2], gv[2];
#pragma unroll
  for (int c = 0; c < 2; ++c) { const int q = wu + 8 * c;
    const int r = 4 * q + (lane >> 4), pch = lane & 15; gk[c] = (long)r * 128 + ((pch ^ (r & 7)) * 8);
    const int st = 2 * q + (lane >> 5), kk = (st >> 2) * 8 + ((lane >> 2) & 7), k = (kk & ~0xC) | ((kk & 4) << 1) | ((kk & 8) >> 1), cc = (st & 3) * 32 + (lane & 3) * 8;
    gv[c] = (long)k * 256 + cc; }
#define DMA16(gp, lp) __builtin_amdgcn_global_load_lds((const unsigned*)(gp), (lds_u32*)(lp), 16, 0, 0)
#define STAGE_K(k0, bb) do { const bf16* kt_ = Kh + (long)(k0) * 128; \
    DMA16(kt_ + gk[0], K_lds + (bb) * 16384 + wu * 1024); DMA16(kt_ + gk[1], K_lds + (bb) * 16384 + (wu + 8) * 1024); } while (0)
#define STAGE_V(k0, bb) do { const bf16* vt_ = Vh + (long)(k0) * 256; \
    DMA16(vt_ + gv[0], V_lds + (bb) * 32768 + wu * 1024); DMA16(vt_ + gv[1], V_lds + (bb) * 32768 + (wu + 8) * 1024); \
    DMA16(vt_ + gv[0] + 128, V_lds + (bb) * 32768 + 16384 + wu * 1024); DMA16(vt_ + gv[1] + 128, V_lds + (bb) * 32768 + 16384 + (wu + 8) * 1024); } while (0)
#define RAWBAR() do { asm volatile("s_waitcnt lgkmcnt(0)" ::: "memory"); __builtin_amdgcn_s_barrier(); asm volatile("" ::: "memory"); } while (0)
#define QKT(PE, PO, b) do { const char* Kb_ = K_lds + (b) * 16384; PE = f32x16{}; PO = f32x16{}; \
    _Pragma("unroll") for (int d0 = 0; d0 < 8; d0 += 2) { \
      const bf16x8 k0_ = *reinterpret_cast<const bf16x8*>(Kb_ + KSWZ(krow, (d0 * 16 + hi * 8) * 2)); \
      const bf16x8 k1_ = *reinterpret_cast<const bf16x8*>(Kb_ + KSWZ(krow, ((d0 + 1) * 16 + hi * 8) * 2)); \
      PE = __builtin_amdgcn_mfma_f32_32x32x16_bf16(k0_, qr[d0], PE, 0, 0, 0); \
      PO = __builtin_amdgcn_mfma_f32_32x32x16_bf16(k1_, qr[d0 + 1], PO, 0, 0, 0); } } while (0)
#define SMX(R0) do { _Pragma("unroll") for (int r = (R0); r < (R0) + 4; ++r) { p[r] = __builtin_amdgcn_exp2f(fmaf(pe[r] + po[r], C, negMc)); lsum += p[r]; } } while (0)
  const int NT = seq / KVBLK;
  char* xw0 = xw; const char* xr0 = xr;
  f32x16 pe, po, p; bf16x8 own0, own1;
  STAGE_K(0, 0); STAGE_V(0, 0); STAGE_K(KVBLK, 1); asm volatile("s_waitcnt vmcnt(0)" ::: "memory"); RAWBAR();
  QKT(pe, po, 0); SMX(0); SMX(4); SMX(8); SMX(12);
  own0 = pk8(p, 0); own1 = pk8(p, 8);
  *(bf16x8*)(xw0) = own0; *(bf16x8*)(xw0 + 16) = own1;
  RAWBAR();
  for (int j = 0; j < NT; ++j) {
    const int buf = j & 1; const bool more = j + 1 < NT;
    if (j + 2 < NT) { STAGE_K((j + 2) * KVBLK, buf); }
    if (more)       { STAGE_V((j + 1) * KVBLK, buf ^ 1); }
    const bf16x8 pt0 = *(const bf16x8*)(xr0 + buf * 16384), pt1 = *(const bf16x8*)(xr0 + buf * 16384 + 16);
    const bf16x8 cur0 = own0, cur1 = own1;
    if (more) { QKT(pe, po, buf ^ 1); }
    const int vo = buf * 32768;
    SBAR();
    pv_pair<0, 1>(o[0], o[1], vbA + vo, cur0, cur1); if (more) SMX(0);
    pv_pair<2, 3>(o[2], o[3], vbA + vo, cur0, cur1); if (more) SMX(4);
    pv_pair<0, 1>(o[0], o[1], vbB + vo, pt0, pt1);   if (more) SMX(8);
    pv_pair<2, 3>(o[2], o[3], vbB + vo, pt0, pt1);   if (more) SMX(12);
    if (more) { own0 = pk8(p, 0); own1 = pk8(p, 8);
      *(bf16x8*)(xw0 + (buf ^ 1) * 16384) = own0; *(bf16x8*)(xw0 + (buf ^ 1) * 16384 + 16) = own1; }
    asm volatile("s_waitcnt vmcnt(0)" ::: "memory");
    RAWBAR();
  }
#undef DMA16
#undef STAGE_K
#undef STAGE_V
#undef RAWBAR
#undef QKT
#undef SMX
  L_lds[(wid * 2 + hi) * 32 + r32] = lsum;
  __syncthreads();
  float rli[16];
#pragma unroll
  for (int r = 0; r < 16; ++r) { const int row = crow(r, hi); const float* lp = L_lds + (g * 4) * 32 + row; rli[r] = __builtin_amdgcn_rcpf((lp[0] + lp[32]) + (lp[64] + lp[96])); }
  float* Ow = Ob + (long)(g * 32) * LDO + kh * 128;
#pragma unroll
  for (int r = 0; r < 16; ++r) { const int orow = crow(r, hi);
    for (int d0 = 0; d0 < 4; ++d0) { float* op = &Ow[(long)orow * LDO + d0 * 32 + r32];
      if (MODE == 0) *op = o[d0][r] * rli[r]; else *op = *op - lam * (o[d0][r] * rli[r]); } }
  asm volatile("s_waitcnt vmcnt(0)" ::: "memory"); __syncthreads();
}
template <int MODE>
__device__ __forceinline__ void attn_pair8_body(const bf16* __restrict__ Qb, const bf16* __restrict__ Kh, const bf16* __restrict__ Vh, unsigned (&o0)[4][8], unsigned short* A2w, const unsigned short* Gw, const float* subw, int seq, char* lds, float lam, float negMc) {
  using St = Stage<bf16>;
  int tid_ = threadIdx.x; asm volatile("" : "+v"(tid_));
  const int tid = tid_, wid = tid >> 6, lane = tid & 63, r32 = lane & 31, hi = lane >> 5, g = wid >> 1, kh = wid & 1;
  char* K_lds = lds; char* V_lds = lds + 32768; char* X_lds = lds + 98304; float* L_lds = (float*)(lds + 114688);
  constexpr float C = SCALE * 1.4426950408889634f;
  f32x16 o[4] = {}; bf16x8 qr[8]; float lsum = 0.f;
  const bf16* Qw = Qb + (long)(g * 32 + r32) * 128 + hi * 8;
#pragma unroll
  for (int d0 = 0; d0 < 8; ++d0) qr[d0] = St::ld8(Qw + d0 * 16);
  const int sr = tid >> 4, sc = (tid & 15) * 8, vst0 = v_st(sr, sc), vst1 = v_st(32 + sr, sc);
  const int vb = (int)(uintptr_t)V_lds + kh * 16384 + v_rd_base(lane);
  const int vbA = vb + 2 * kh * 4096, vbB = vb + 2 * (1 - kh) * 4096;
  const int krow = 32 * kh + r32;
  char* xw = X_lds + (wid * 64 + lane) * 32; const char* xr = X_lds + ((wid ^ 1) * 64 + lane) * 32;
  typedef __attribute__((address_space(3))) unsigned lds_u32;
  const int wu = __builtin_amdgcn_readfirstlane(wid);
  long gk[2], gv[2];
#pragma unroll
  for (int c = 0; c < 2; ++c) { const int q = wu + 8 * c;
    const int r = 4 * q + (lane >> 4), pch = lane & 15; gk[c] = (long)r * 128 + ((pch ^ (r & 7)) * 8);
    const int st = 2 * q + (lane >> 5), kk = (st >> 2) * 8 + ((lane >> 2) & 7), k = (kk & ~0xC) | ((kk & 4) << 1) | ((kk & 8) >> 1), cc = (st & 3) * 32 + (lane & 3) * 8;
    gv[c] = (long)k * 256 + cc; }
#define DMA16(gp, lp) __builtin_amdgcn_global_load_lds((const unsigned*)(gp), (lds_u32*)(lp), 16, 0, 0)
#define STAGE(k0, bb) do { const bf16* kt_ = Kh + (long)(k0) * 128; const bf16* vt_ = Vh + (long)(k0) * 256; \
    DMA16(kt_ + gk[0], K_lds + (bb) * 16384 + wu * 1024); DMA16(kt_ + gk[1], K_lds + (bb) * 16384 + (wu + 8) * 1024); \
    DMA16(vt_ + gv[0], V_lds + (bb) * 32768 + wu * 1024); DMA16(vt_ + gv[1], V_lds + (bb) * 32768 + (wu + 8) * 1024); \
    DMA16(vt_ + gv[0] + 128, V_lds + (bb) * 32768 + 16384 + wu * 1024); DMA16(vt_ + gv[1] + 128, V_lds + (bb) * 32768 + 16384 + (wu + 8) * 1024); } while (0)
#define RAWBAR() do { asm volatile("s_waitcnt lgkmcnt(0)" ::: "memory"); __builtin_amdgcn_s_barrier(); asm volatile("" ::: "memory"); } while (0)
  const int NT = seq / KVBLK;
  STAGE(0, 0); asm volatile("s_waitcnt vmcnt(0)" ::: "memory"); RAWBAR();
  for (int j = 0; j < NT; ++j) {
    const int buf = j & 1;
    if (j + 1 < NT) { STAGE((j + 1) * KVBLK, buf ^ 1); }
    const char* Kb = K_lds + buf * 16384;
    f32x16 pe = {}, po = {};
#pragma unroll
    for (int d0 = 0; d0 < 8; d0 += 2) {
      const bf16x8 k0 = *reinterpret_cast<const bf16x8*>(Kb + KSWZ(krow, (d0 * 16 + hi * 8) * 2));
      const bf16x8 k1 = *reinterpret_cast<const bf16x8*>(Kb + KSWZ(krow, ((d0 + 1) * 16 + hi * 8) * 2));
      pe = __builtin_amdgcn_mfma_f32_32x32x16_bf16(k0, qr[d0], pe, 0, 0, 0);
      po = __builtin_amdgcn_mfma_f32_32x32x16_bf16(k1, qr[d0 + 1], po, 0, 0, 0); }
    f32x16 p;
#pragma unroll
    for (int r = 0; r < 16; ++r) p[r] = __builtin_amdgcn_exp2f(fmaf(pe[r] + po[r], C, negMc));
    float ps = 0.f;
#pragma unroll
    for (int r = 0; r < 16; ++r) ps += p[r];
    lsum += ps;
    const bf16x8 own0 = pk8(p, 0), own1 = pk8(p, 8);
    *(bf16x8*)(xw) = own0; *(bf16x8*)(xw + 16) = own1;
    const int vo = buf * 32768;
    SBAR();
    pv_pair<0, 1>(o[0], o[1], vbA + vo, own0, own1); pv_pair<2, 3>(o[2], o[3], vbA + vo, own0, own1);
    RAWBAR();
    const bf16x8 pt0 = *(const bf16x8*)(xr), pt1 = *(const bf16x8*)(xr + 16);
    SBAR();
    pv_pair<0, 1>(o[0], o[1], vbB + vo, pt0, pt1); pv_pair<2, 3>(o[2], o[3], vbB + vo, pt0, pt1);
    asm volatile("s_waitcnt vmcnt(0)" ::: "memory");
    RAWBAR();
  }
#undef DMA16
#undef STAGE
#undef RAWBAR
  L_lds[(wid * 2 + hi) * 32 + r32] = lsum;
  __syncthreads();
  float rli[16];
#pragma unroll
  for (int r = 0; r < 16; ++r) { const int row = crow(r, hi); const float* lp = L_lds + (g * 4) * 32 + row; rli[r] = __builtin_amdgcn_rcpf((lp[0] + lp[32]) + (lp[64] + lp[96])); }
  if (MODE == 0) {
#pragma unroll
    for (int d0 = 0; d0 < 4; ++d0)
#pragma unroll
      for (int r = 0; r < 16; r += 2) o0[d0][r >> 1] = cvtpk(o[d0][r] * rli[r], o[d0][r + 1] * rli[r + 1]);
    __syncthreads();
  } else {
    float ssq[16];
#pragma unroll
    for (int r = 0; r < 16; ++r) { float s = 0.f;
#pragma unroll
      for (int d0 = 0; d0 < 4; ++d0) { const unsigned w_ = o0[d0][r >> 1]; const float v = __builtin_bit_cast(float, (r & 1) ? (w_ & 0xffff0000u) : (w_ << 16)) - lam * (o[d0][r] * rli[r]); o[d0][r] = v; s += v * v; }
      s += __shfl_xor(s, 1); s += __shfl_xor(s, 2); s += __shfl_xor(s, 4); s += __shfl_xor(s, 8); s += __shfl_xor(s, 16);
      ssq[r] = s; }
    __syncthreads();
    if (r32 == 0) {
#pragma unroll
      for (int r = 0; r < 16; ++r) L_lds[wid * 32 + crow(r, hi)] = ssq[r]; }
    __syncthreads();
    constexpr float ONE_M_LI = 1.f - 0.35550906759f;
    float sw[4];
#pragma unroll
    for (int d0 = 0; d0 < 4; ++d0) sw[d0] = subw[kh * 128 + d0 * 32 + r32] * ONE_M_LI;
    char* zt = lds + wid * 8704;
#pragma unroll
    for (int r = 0; r < 16; ++r) { const int orow = crow(r, hi);
      const float rstd = rsqrtf((L_lds[wid * 32 + orow] + L_lds[(wid ^ 1) * 32 + orow]) * (1.f / 256.f) + 1e-6f);
#pragma unroll
      for (int d0 = 0; d0 < 4; ++d0) { const float z = o[d0][r] * rstd * sw[d0];
        *(unsigned short*)(zt + orow * 272 + (d0 * 32 + r32) * 2) = (unsigned short)(cvtpk(z, z) & 0xffffu); } }
    asm volatile("s_waitcnt lgkmcnt(0)" ::: "memory");
    u32x4 gq[8];
#pragma unroll
    for (int i = 0; i < 8; ++i) { const int id = lane + 64 * i; gq[i] = *(const u32x4*)(Gw + (long)(g * 32 + (id >> 4)) * 2048 + kh * 128 + (id & 15) * 8); }
#pragma unroll
    for (int i = 0; i < 8; ++i) { const int id = lane + 64 * i, row = id >> 4, cc = id & 15;
      const u32x4 zz = *(const u32x4*)(zt + row * 272 + cc * 16);
      unsigned yo[4];
#pragma unroll
      for (int k = 0; k < 4; ++k) { const unsigned zw = zz[k], gw_ = gq[i][k];
        const float z0 = __builtin_bit_cast(float, zw << 16), z1 = __builtin_bit_cast(float, zw & 0xffff0000u);
        const float g0 = __builtin_bit_cast(float, gw_ << 16), g1 = __builtin_bit_cast(float, gw_ & 0xffff0000u);
        yo[k] = cvtpk(z0 * (g0 / (1.f + __expf(-g0))), z1 * (g1 / (1.f + __expf(-g1)))); }
      *(u32x4*)(A2w + (long)(g * 32 + row) * 2048 + kh * 128 + cc * 8) = (u32x4){yo[0], yo[1], yo[2], yo[3]}; }
    asm volatile("s_waitcnt vmcnt(0)" ::: "memory"); __syncthreads();
  }
}
template <int MODE>
__device__ __forceinline__ void attn_pair9_body(const bf16* __restrict__ Qb, const bf16* __restrict__ Kh, const bf16* __restrict__ Vh, unsigned (&o0)[4][8], unsigned short* A2w, const unsigned short* Gw, const float* subw, int seq, char* lds, float lam, float negMc) {
  using St = Stage<bf16>;
  int tid_ = threadIdx.x; asm volatile("" : "+v"(tid_));
  const int tid = tid_, wid = tid >> 6, lane = tid & 63, r32 = lane & 31, hi = lane >> 5, g = wid >> 1, kh = wid & 1;
  char* K_lds = lds; char* V_lds = lds + 32768; char* X_lds = lds + 98304; float* L_lds = (float*)(lds + 114688);
  constexpr float C = SCALE * 1.4426950408889634f;
  f32x16 o[4] = {}; bf16x8 qr[8]; float lsum = 0.f;
  const bf16* Qw = Qb + (long)(g * 32 + r32) * 128 + hi * 8;
#pragma unroll
  for (int d0 = 0; d0 < 8; ++d0) qr[d0] = St::ld8(Qw + d0 * 16);
  const int sr = tid >> 4, sc = (tid & 15) * 8, vst0 = v_st(sr, sc), vst1 = v_st(32 + sr, sc);
  const int vb = (int)(uintptr_t)V_lds + kh * 16384 + v_rd_base(lane);
  const int vbA = vb + 2 * kh * 4096, vbB = vb + 2 * (1 - kh) * 4096;
  const int krow = 32 * kh + r32;
  char* xw = X_lds + (wid * 64 + lane) * 32; const char* xr = X_lds + ((wid ^ 1) * 64 + lane) * 32;
  typedef __attribute__((address_space(3))) unsigned lds_u32;
  const int wu = __builtin_amdgcn_readfirstlane(wid);
  const bool early = wu < 4; const int w4 = wu & 3;
  long gk[4], gv[4];
#pragma unroll
  for (int c = 0; c < 4; ++c) { const int q = w4 + 4 * c;
    const int r = 4 * q + (lane >> 4), pch = lane & 15; gk[c] = (long)r * 128 + ((pch ^ (r & 7)) * 8);
    const int st = 2 * q + (lane >> 5), kk = (st >> 2) * 8 + ((lane >> 2) & 7), k = (kk & ~0xC) | ((kk & 4) << 1) | ((kk & 8) >> 1), cc = (st & 3) * 32 + (lane & 3) * 8;
    gv[c] = (long)k * 256 + cc; }
#define DMA16(gp, lp) __builtin_amdgcn_global_load_lds((const unsigned*)(gp), (lds_u32*)(lp), 16, 0, 0)
#define STAGE_K(k0, bb) do { const bf16* kt_ = Kh + (long)(k0) * 128; \
    _Pragma("unroll") for (int c = 0; c < 4; ++c) DMA16(kt_ + gk[c], K_lds + (bb) * 16384 + (w4 + 4 * c) * 1024); } while (0)
#define STAGE_V(k0, bb) do { const bf16* vt_ = Vh + (long)(k0) * 256; \
    _Pragma("unroll") for (int c = 0; c < 4; ++c) { DMA16(vt_ + gv[c], V_lds + (bb) * 32768 + (w4 + 4 * c) * 1024); DMA16(vt_ + gv[c] + 128, V_lds + (bb) * 32768 + 16384 + (w4 + 4 * c) * 1024); } } while (0)
#define RAWBAR() do { asm volatile("s_waitcnt lgkmcnt(0)" ::: "memory"); __builtin_amdgcn_s_barrier(); asm volatile("" ::: "memory"); } while (0)
  const int NT = seq / KVBLK;
  if (early) { STAGE_V(0, 0); } else { STAGE_K(0, 0); STAGE_K(KVBLK, 1); }
  asm volatile("s_waitcnt vmcnt(0)" ::: "memory"); RAWBAR();
  if (!early) RAWBAR();
  if (!early) __builtin_amdgcn_s_setprio(1);
  bf16x8 own0, own1;
  for (int j = 0; j < NT; ++j) {
    const int buf = j & 1;
    { const char* Kb = K_lds + buf * 16384;
      f32x16 pe = {}, po = {};
#pragma unroll
      for (int d0 = 0; d0 < 8; d0 += 2) {
        const bf16x8 k0 = *reinterpret_cast<const bf16x8*>(Kb + KSWZ(krow, (d0 * 16 + hi * 8) * 2));
        const bf16x8 k1 = *reinterpret_cast<const bf16x8*>(Kb + KSWZ(krow, ((d0 + 1) * 16 + hi * 8) * 2));
        pe = __builtin_amdgcn_mfma_f32_32x32x16_bf16(k0, qr[d0], pe, 0, 0, 0);
        po = __builtin_amdgcn_mfma_f32_32x32x16_bf16(k1, qr[d0 + 1], po, 0, 0, 0); }
      f32x16 p;
#pragma unroll
      for (int r = 0; r < 16; ++r) p[r] = __builtin_amdgcn_exp2f(fmaf(pe[r] + po[r], C, negMc));
      float ps = 0.f;
#pragma unroll
      for (int r = 0; r < 16; ++r) ps += p[r];
      lsum += ps;
      own0 = pk8(p, 0); own1 = pk8(p, 8);
      *(bf16x8*)(xw) = own0; *(bf16x8*)(xw + 16) = own1; }
    asm volatile("s_waitcnt vmcnt(0)" ::: "memory");
    RAWBAR();
    if (early) { if (j + 1 < NT) { STAGE_V((j + 1) * KVBLK, buf ^ 1); } }
    else       { if (j + 2 < NT) { STAGE_K((j + 2) * KVBLK, buf); } }
    const bf16x8 pt0 = *(const bf16x8*)(xr), pt1 = *(const bf16x8*)(xr + 16);
    const int vo = buf * 32768;
    SBAR();
    pv_pair_np<0, 1>(o[0], o[1], vbA + vo, own0, own1); pv_pair_np<2, 3>(o[2], o[3], vbA + vo, own0, own1);
    pv_pair_np<0, 1>(o[0], o[1], vbB + vo, pt0, pt1); pv_pair_np<2, 3>(o[2], o[3], vbB + vo, pt0, pt1);
    RAWBAR();
  }
  __builtin_amdgcn_s_setprio(0);
  if (early) RAWBAR();
#undef DMA16
#undef STAGE_K
#undef STAGE_V
#undef RAWBAR
  L_lds[(wid * 2 + hi) * 32 + r32] = lsum;
  __syncthreads();
  float rli[16];
#pragma unroll
  for (int r = 0; r < 16; ++r) { const int row = crow(r, hi); const float* lp = L_lds + (g * 4) * 32 + row; rli[r] = __builtin_amdgcn_rcpf((lp[0] + lp[32]) + (lp[64] + lp[96])); }
  if (MODE == 0) {
#pragma unroll
    for (int d0 = 0; d0 < 4; ++d0)
#pragma unroll
      for (int r = 0; r < 16; r += 2) o0[d0][r >> 1] = cvtpk(o[d0][r] * rli[r], o[d0][r + 1] * rli[r + 1]);
    __syncthreads();
  } else {
    float ssq[16];
#pragma unroll
    for (int r = 0; r < 16; ++r) { float s = 0.f;
#pragma unroll
      for (int d0 = 0; d0 < 4; ++d0) { const unsigned w_ = o0[d0][r >> 1]; const float v = __builtin_bit_cast(float, (r & 1) ? (w_ & 0xffff0000u) : (w_ << 16)) - lam * (o[d0][r] * rli[r]); o[d0][r] = v; s += v * v; }
      s += __shfl_xor(s, 1); s += __shfl_xor(s, 2); s += __shfl_xor(s, 4); s += __shfl_xor(s, 8); s += __shfl_xor(s, 16);
      ssq[r] = s; }
    __syncthreads();
    if (r32 == 0) {
#pragma unroll
      for (int r = 0; r < 16; ++r) L_lds[wid * 32 + crow(r, hi)] = ssq[r]; }
    __syncthreads();
    constexpr float ONE_M_LI = 1.f - 0.35550906759f;
    float sw[4];
#pragma unroll
    for (int d0 = 0; d0 < 4; ++d0) sw[d0] = subw[kh * 128 + d0 * 32 + r32] * ONE_M_LI;
    char* zt = lds + wid * 8704;
#pragma unroll
    for (int r = 0; r < 16; ++r) { const int orow = crow(r, hi);
      const float rstd = rsqrtf((L_lds[wid * 32 + orow] + L_lds[(wid ^ 1) * 32 + orow]) * (1.f / 256.f) + 1e-6f);
#pragma unroll
      for (int d0 = 0; d0 < 4; ++d0) { const float z = o[d0][r] * rstd * sw[d0];
        *(unsigned short*)(zt + orow * 272 + (d0 * 32 + r32) * 2) = (unsigned short)(cvtpk(z, z) & 0xffffu); } }
    asm volatile("s_waitcnt lgkmcnt(0)" ::: "memory");
    u32x4 gq[8];
#pragma unroll
    for (int i = 0; i < 8; ++i) { const int id = lane + 64 * i; gq[i] = *(const u32x4*)(Gw + (long)(g * 32 + (id >> 4)) * 2048 + kh * 128 + (id & 15) * 8); }
#pragma unroll
    for (int i = 0; i < 8; ++i) { const int id = lane + 64 * i, row = id >> 4, cc = id & 15;
      const u32x4 zz = *(const u32x4*)(zt + row * 272 + cc * 16);
      unsigned yo[4];
#pragma unroll
      for (int k = 0; k < 4; ++k) { const unsigned zw = zz[k], gw_ = gq[i][k];
        const float z0 = __builtin_bit_cast(float, zw << 16), z1 = __builtin_bit_cast(float, zw & 0xffff0000u);
        const float g0 = __builtin_bit_cast(float, gw_ << 16), g1 = __builtin_bit_cast(float, gw_ & 0xffff0000u);
        yo[k] = cvtpk(z0 * (g0 / (1.f + __expf(-g0))), z1 * (g1 / (1.f + __expf(-g1)))); }
      *(u32x4*)(A2w + (long)(g * 32 + row) * 2048 + kh * 128 + cc * 8) = (u32x4){yo[0], yo[1], yo[2], yo[3]}; }
    asm volatile("s_waitcnt vmcnt(0)" ::: "memory"); __syncthreads();
  }
}
template <int MODE>
__device__ __forceinline__ void attn_ks_body(const bf16* __restrict__ Qb, const bf16* __restrict__ Kh, const bf16* __restrict__ Vh, float* Ob, unsigned short* A2w, const unsigned short* Gw, const float* subw,
                                             int seq, char* lds, float lam, float negMc) {
  using St = Stage<bf16>;
  int tid_ = threadIdx.x; asm volatile("" : "+v"(tid_));
  const int tid = tid_, wid = tid >> 6, lane = tid & 63, r32 = lane & 31, hi = lane >> 5, g = wid >> 1, kh = wid & 1;
  char* K_lds = lds; char* V_lds = lds + 32768; float* L_lds = (float*)(lds + 131072);
  constexpr float C = SCALE * 1.4426950408889634f;
  f32x16 o[8] = {}; bf16x8 qr[8]; float lsum = 0.f;
  const bf16* Qw = Qb + (long)(g * 32 + r32) * 128 + hi * 8;
#pragma unroll
  for (int d0 = 0; d0 < 8; ++d0) qr[d0] = St::ld8(Qw + d0 * 16);
  const int vb0 = (int)(uintptr_t)V_lds + v_rd_base(lane) + 2 * kh * 4096;
  const int krow = 32 * kh + r32;
  typedef __attribute__((address_space(3))) unsigned lds_u32;
  const int wu = __builtin_amdgcn_readfirstlane(wid);
  long gk[2], gv[2];
#pragma unroll
  for (int c = 0; c < 2; ++c) { const int q = wu + 8 * c;
    const int r = 4 * q + (lane >> 4), pch = lane & 15; gk[c] = (long)r * 128 + ((pch ^ (r & 7)) * 8);
    const int st = 2 * q + (lane >> 5), kk = (st >> 2) * 8 + ((lane >> 2) & 7), k = (kk & ~0xC) | ((kk & 4) << 1) | ((kk & 8) >> 1), cc = (st & 3) * 32 + (lane & 3) * 8;
    gv[c] = (long)k * 256 + cc; }
#define DMA16(gp, lp) __builtin_amdgcn_global_load_lds((const unsigned*)(gp), (lds_u32*)(lp), 16, 0, 0)
#define STAGE(k0, bb) do { const bf16* kt_ = Kh + (long)(k0) * 128; const bf16* vt_ = Vh + (long)(k0) * 256; \
    DMA16(kt_ + gk[0], K_lds + (bb) * 16384 + wu * 1024); DMA16(kt_ + gk[1], K_lds + (bb) * 16384 + (wu + 8) * 1024); \
    DMA16(vt_ + gv[0], V_lds + (bb) * 32768 + wu * 1024); DMA16(vt_ + gv[1], V_lds + (bb) * 32768 + (wu + 8) * 1024); \
    DMA16(vt_ + gv[0] + 128, V_lds + (bb) * 32768 + 16384 + wu * 1024); DMA16(vt_ + gv[1] + 128, V_lds + (bb) * 32768 + 16384 + (wu + 8) * 1024); } while (0)
#define RAWBAR() do { asm volatile("s_waitcnt lgkmcnt(0)" ::: "memory"); __builtin_amdgcn_s_barrier(); asm volatile("" ::: "memory"); } while (0)
  const int NT = seq / KVBLK;
  STAGE(0, 0); asm volatile("s_waitcnt vmcnt(0)" ::: "memory"); RAWBAR();
  if (false) __builtin_amdgcn_s_setprio(1);
  for (int j = 0; j < NT; ++j) {
    const int buf = j & 1;
    if (j + 1 < NT) { STAGE((j + 1) * KVBLK, buf ^ 1); }
    const char* Kb = K_lds + buf * 16384;
    f32x16 pe = {}, po = {};
#pragma unroll
    for (int d0 = 0; d0 < 8; d0 += 2) {
      const bf16x8 k0 = *reinterpret_cast<const bf16x8*>(Kb + KSWZ(krow, (d0 * 16 + hi * 8) * 2));
      const bf16x8 k1 = *reinterpret_cast<const bf16x8*>(Kb + KSWZ(krow, ((d0 + 1) * 16 + hi * 8) * 2));
      pe = __builtin_amdgcn_mfma_f32_32x32x16_bf16(k0, qr[d0], pe, 0, 0, 0);
      po = __builtin_amdgcn_mfma_f32_32x32x16_bf16(k1, qr[d0 + 1], po, 0, 0, 0); }
    const int vo = vb0 + buf * 32768;
    s16x4 R0_[8], R1_[8];
    PVR(R0_, 0, 1, vo);
    f32x16 p;
#pragma unroll
    for (int r = 0; r < 16; ++r) p[r] = __builtin_amdgcn_exp2f(fmaf(pe[r] + po[r], C, negMc));
    float ps = 0.f;
#pragma unroll
    for (int r = 0; r < 16; ++r) ps += p[r];
    lsum += ps;
    const bf16x8 own0 = pk8(p, 0), own1 = pk8(p, 8);
    SBAR();
    PV_TAIL4(o, vo, vo + 16384, own0, own1);
    asm volatile("s_waitcnt vmcnt(0)" ::: "memory");
    RAWBAR();
  }
#undef DMA16
#undef STAGE
#undef RAWBAR
  __builtin_amdgcn_s_setprio(0);
  L_lds[(wid * 2 + hi) * 32 + r32] = lsum;
#define XS_WRITE(OV, BASE) do { float* xs_ = (float*)(lds + (BASE)) + ((g * 4) * 64 + lane) * 16; \
    _Pragma("unroll") for (int d0 = 0; d0 < 4; ++d0) { float* xp = xs_ + d0 * 64 * 16; \
      _Pragma("unroll") for (int q4 = 0; q4 < 4; ++q4) *(f32x4v*)(xp + 4 * q4) = (f32x4v){OV[d0][4 * q4], OV[d0][4 * q4 + 1], OV[d0][4 * q4 + 2], OV[d0][4 * q4 + 3]}; } } while (0)
#define XS_ADD(OV, BASE) do { const float* xs_ = (const float*)(lds + (BASE)) + ((g * 4) * 64 + lane) * 16; \
    _Pragma("unroll") for (int d0 = 0; d0 < 4; ++d0) { const float* xp = xs_ + d0 * 64 * 16; \
      _Pragma("unroll") for (int q4 = 0; q4 < 4; ++q4) { const f32x4v t = *(const f32x4v*)(xp + 4 * q4); OV[d0][4 * q4] += t[0]; OV[d0][4 * q4 + 1] += t[1]; OV[d0][4 * q4 + 2] += t[2]; OV[d0][4 * q4 + 3] += t[3]; } } } while (0)
  f32x16* olo = o; f32x16* ohi = o + 4;
  if (kh) { XS_WRITE(olo, 0); } else { XS_WRITE(ohi, 65536); }
  __syncthreads();
  if (kh) { XS_ADD(ohi, 65536);
#pragma unroll
    for (int d0 = 0; d0 < 4; ++d0) o[d0] = o[4 + d0]; }
  else { XS_ADD(olo, 0); }
#undef XS_WRITE
#undef XS_ADD
  float rli[16];
#pragma unroll
  for (int r = 0; r < 16; ++r) { const int row = crow(r, hi); const float* lp = L_lds + (g * 4) * 32 + row; rli[r] = __builtin_amdgcn_rcpf((lp[0] + lp[32]) + (lp[64] + lp[96])); }
  float* Ow = Ob + (long)(g * 32) * LDO + kh * 128;
  if (MODE == 0) {
#pragma unroll
    for (int r = 0; r < 16; ++r) { const int orow = crow(r, hi);
#pragma unroll
      for (int d0 = 0; d0 < 4; ++d0) Ow[(long)orow * LDO + d0 * 32 + r32] = o[d0][r] * rli[r]; }
    asm volatile("s_waitcnt vmcnt(0)" ::: "memory"); __syncthreads();
  } else {
    float ssq[16];
#pragma unroll
    for (int r = 0; r < 16; ++r) { const int orow = crow(r, hi); float s = 0.f;
#pragma unroll
      for (int d0 = 0; d0 < 4; ++d0) { const float v = Ow[(long)orow * LDO + d0 * 32 + r32] - lam * (o[d0][r] * rli[r]); o[d0][r] = v; s += v * v; }
      s += __shfl_xor(s, 1); s += __shfl_xor(s, 2); s += __shfl_xor(s, 4); s += __shfl_xor(s, 8); s += __shfl_xor(s, 16);
      ssq[r] = s; }
    __syncthreads();
    if (r32 == 0) {
#pragma unroll
      for (int r = 0; r < 16; ++r) L_lds[wid * 32 + crow(r, hi)] = ssq[r]; }
    __syncthreads();
    constexpr float ONE_M_LI = 1.f - 0.35550906759f;
    float sw[4];
#pragma unroll
    for (int d0 = 0; d0 < 4; ++d0) sw[d0] = subw[kh * 128 + d0 * 32 + r32] * ONE_M_LI;
    char* zt = lds + wid * 8704;
#pragma unroll
    for (int r = 0; r < 16; ++r) { const int orow = crow(r, hi);
      const float rstd = rsqrtf((L_lds[wid * 32 + orow] + L_lds[(wid ^ 1) * 32 + orow]) * (1.f / 256.f) + 1e-6f);
#pragma unroll
      for (int d0 = 0; d0 < 4; ++d0) { const float z = o[d0][r] * rstd * sw[d0];
        *(unsigned short*)(zt + orow * 272 + (d0 * 32 + r32) * 2) = (unsigned short)(cvtpk(z, z) & 0xffffu); } }
    asm volatile("s_waitcnt lgkmcnt(0)" ::: "memory");
    u32x4 gq[8];
#pragma unroll
    for (int i = 0; i < 8; ++i) { const int id = lane + 64 * i; gq[i] = *(const u32x4*)(Gw + (long)(g * 32 + (id >> 4)) * 2048 + kh * 128 + (id & 15) * 8); }
#pragma unroll
    for (int i = 0; i < 8; ++i) { const int id = lane + 64 * i, row = id >> 4, cc = id & 15;
      const u32x4 zz = *(const u32x4*)(zt + row * 272 + cc * 16);
      unsigned yo[4];
#pragma unroll
      for (int k = 0; k < 4; ++k) { const unsigned zw = zz[k], gw_ = gq[i][k];
        const float z0 = __builtin_bit_cast(float, zw << 16), z1 = __builtin_bit_cast(float, zw & 0xffff0000u);
        const float g0 = __builtin_bit_cast(float, gw_ << 16), g1 = __builtin_bit_cast(float, gw_ & 0xffff0000u);
        yo[k] = cvtpk(z0 * (g0 / (1.f + __expf(-g0))), z1 * (g1 / (1.f + __expf(-g1)))); }
      *(u32x4*)(A2w + (long)(g * 32 + row) * 2048 + kh * 128 + cc * 8) = (u32x4){yo[0], yo[1], yo[2], yo[3]}; }
    asm volatile("s_waitcnt vmcnt(0)" ::: "memory"); __syncthreads();
  }
}
template <int MODE>
__device__ __forceinline__ void attn_ks2_body(const bf16* __restrict__ Qb, const bf16* __restrict__ Kh, const bf16* __restrict__ Vh, float* Ob, unsigned short* A2w, const unsigned short* Gw, const float* subw,
                                             int seq, char* lds, float lam, float negMc) {
  using St = Stage<bf16>;
  int tid_ = threadIdx.x; asm volatile("" : "+v"(tid_));
  const int tid = tid_, wid = tid >> 6, lane = tid & 63, r32 = lane & 31, hi = lane >> 5, g = wid >> 1, kh = wid & 1;
  char* K_lds = lds; char* V_lds = lds + 49152; float* L_lds = (float*)(lds + 131072);
  constexpr float C = SCALE * 1.4426950408889634f;
  f32x16 o[8] = {}; bf16x8 qr[8]; float lsum = 0.f;
  const bf16* Qw = Qb + (long)(g * 32 + r32) * 128 + hi * 8;
#pragma unroll
  for (int d0 = 0; d0 < 8; ++d0) qr[d0] = St::ld8(Qw + d0 * 16);
  const int vb0 = (int)(uintptr_t)V_lds + v_rd_base(lane) + 2 * kh * 4096;
  const int krow = 32 * kh + r32;
  typedef __attribute__((address_space(3))) unsigned lds_u32;
  const int wu = __builtin_amdgcn_readfirstlane(wid);
  long gk[2], gv[2];
#pragma unroll
  for (int c = 0; c < 2; ++c) { const int q = wu + 8 * c;
    const int r = 4 * q + (lane >> 4), pch = lane & 15; gk[c] = (long)r * 128 + ((pch ^ (r & 7)) * 8);
    const int st = 2 * q + (lane >> 5), kk = (st >> 2) * 8 + ((lane >> 2) & 7), k = (kk & ~0xC) | ((kk & 4) << 1) | ((kk & 8) >> 1), cc = (st & 3) * 32 + (lane & 3) * 8;
    gv[c] = (long)k * 256 + cc; }
#define DMA16(gp, lp) __builtin_amdgcn_global_load_lds((const unsigned*)(gp), (lds_u32*)(lp), 16, 0, 0)
#define STAGE(k0, bb) do { const bf16* kt_ = Kh + (long)(k0) * 128; const bf16* vt_ = Vh + (long)(k0) * 256; \
    DMA16(kt_ + gk[0], K_lds + (bb) * 16384 + wu * 1024); DMA16(kt_ + gk[1], K_lds + (bb) * 16384 + (wu + 8) * 1024); \
    DMA16(vt_ + gv[0], V_lds + (bb) * 32768 + wu * 1024); DMA16(vt_ + gv[1], V_lds + (bb) * 32768 + (wu + 8) * 1024); \
    DMA16(vt_ + gv[0] + 128, V_lds + (bb) * 32768 + 16384 + wu * 1024); DMA16(vt_ + gv[1] + 128, V_lds + (bb) * 32768 + 16384 + (wu + 8) * 1024); } while (0)
#define RAWBAR() do { asm volatile("s_waitcnt lgkmcnt(0)" ::: "memory"); __builtin_amdgcn_s_barrier(); asm volatile("" ::: "memory"); } while (0)
  const int NT = seq / KVBLK;
  const bool early = wu < 4;
#define STAGE_K(k0, kb) do { const bf16* kt_ = Kh + (long)(k0) * 128; DMA16(kt_ + gk[0], K_lds + (kb) * 16384 + wu * 1024); DMA16(kt_ + gk[1], K_lds + (kb) * 16384 + (wu + 8) * 1024); } while (0)
#define STAGE_V(k0, vb_) do { const bf16* vt_ = Vh + (long)(k0) * 256; \
    DMA16(vt_ + gv[0], V_lds + (vb_) * 32768 + wu * 1024); DMA16(vt_ + gv[1], V_lds + (vb_) * 32768 + (wu + 8) * 1024); \
    DMA16(vt_ + gv[0] + 128, V_lds + (vb_) * 32768 + 16384 + wu * 1024); DMA16(vt_ + gv[1] + 128, V_lds + (vb_) * 32768 + 16384 + (wu + 8) * 1024); } while (0)
#define SCORE(kb, OWN0, OWN1) do { const char* Kb = K_lds + (kb) * 16384; f32x16 pe = {}, po = {}; \
    _Pragma("unroll") for (int d0 = 0; d0 < 8; d0 += 2) { \
      const bf16x8 k0 = *reinterpret_cast<const bf16x8*>(Kb + KSWZ(krow, (d0 * 16 + hi * 8) * 2)); \
      const bf16x8 k1 = *reinterpret_cast<const bf16x8*>(Kb + KSWZ(krow, ((d0 + 1) * 16 + hi * 8) * 2)); \
      pe = __builtin_amdgcn_mfma_f32_32x32x16_bf16(k0, qr[d0], pe, 0, 0, 0); \
      po = __builtin_amdgcn_mfma_f32_32x32x16_bf16(k1, qr[d0 + 1], po, 0, 0, 0); } \
    f32x16 p; _Pragma("unroll") for (int r = 0; r < 16; ++r) p[r] = __builtin_amdgcn_exp2f(fmaf(pe[r] + po[r], C, negMc)); \
    float ps = 0.f; _Pragma("unroll") for (int r = 0; r < 16; ++r) ps += p[r]; lsum += ps; \
    OWN0 = pk8(p, 0); OWN1 = pk8(p, 8); } while (0)
#define PVALL(vb_, OWN0, OWN1) do { const int vo = vb0 + (vb_) * 32768; \
    pv_pair<0, 1>(o[0], o[1], vo, OWN0, OWN1); pv_pair<2, 3>(o[2], o[3], vo, OWN0, OWN1); \
    pv_pair<0, 1>(o[4], o[5], vo + 16384, OWN0, OWN1); pv_pair<2, 3>(o[6], o[7], vo + 16384, OWN0, OWN1); } while (0)
  STAGE_K(0, 0); STAGE_K(KVBLK, 1); STAGE_V(0, 0); asm volatile("s_waitcnt vmcnt(0)" ::: "memory"); RAWBAR();
  bf16x8 own0, own1;
  if (!early) { SCORE(0, own0, own1); }
  int kb0 = 0, kb1 = 1, kb2 = 2;
  for (int j = 0; j < NT; ++j) {
    const int vbuf = j & 1;
    if (j + 2 < NT) { STAGE_K((j + 2) * KVBLK, kb2); }
    if (j + 1 < NT) { STAGE_V((j + 1) * KVBLK, vbuf ^ 1); }
    if (early) { SCORE(kb0, own0, own1); }
    const bf16x8 c0 = own0, c1 = own1;
    SBAR();
    PVALL(vbuf, c0, c1);
    SBAR();
    if (!early) { if (j + 1 < NT) { SCORE(kb1, own0, own1); } }
    asm volatile("s_waitcnt vmcnt(0)" ::: "memory");
    RAWBAR();
    { const int t_ = kb0; kb0 = kb1; kb1 = kb2; kb2 = t_; }
  }
#undef STAGE_K
#undef STAGE_V
#undef SCORE
#undef PVALL
#undef DMA16
#undef STAGE
#undef RAWBAR
  L_lds[(wid * 2 + hi) * 32 + r32] = lsum;
#define XS_WRITE(OV, BASE) do { float* xs_ = (float*)(lds + (BASE)) + ((g * 4) * 64 + lane) * 16; \
    _Pragma("unroll") for (int d0 = 0; d0 < 4; ++d0) { float* xp = xs_ + d0 * 64 * 16; \
      _Pragma("unroll") for (int q4 = 0; q4 < 4; ++q4) *(f32x4v*)(xp + 4 * q4) = (f32x4v){OV[d0][4 * q4], OV[d0][4 * q4 + 1], OV[d0][4 * q4 + 2], OV[d0][4 * q4 + 3]}; } } while (0)
#define XS_ADD(OV, BASE) do { const float* xs_ = (const float*)(lds + (BASE)) + ((g * 4) * 64 + lane) * 16; \
    _Pragma("unroll") for (int d0 = 0; d0 < 4; ++d0) { const float* xp = xs_ + d0 * 64 * 16; \
      _Pragma("unroll") for (int q4 = 0; q4 < 4; ++q4) { const f32x4v t = *(const f32x4v*)(xp + 4 * q4); OV[d0][4 * q4] += t[0]; OV[d0][4 * q4 + 1] += t[1]; OV[d0][4 * q4 + 2] += t[2]; OV[d0][4 * q4 + 3] += t[3]; } } } while (0)
  f32x16* olo = o; f32x16* ohi = o + 4;
  if (kh) { XS_WRITE(olo, 0); } else { XS_WRITE(ohi, 65536); }
  __syncthreads();
  if (kh) { XS_ADD(ohi, 65536);
#pragma unroll
    for (int d0 = 0; d0 < 4; ++d0) o[d0] = o[4 + d0]; }
  else { XS_ADD(olo, 0); }
#undef XS_WRITE
#undef XS_ADD
  float rli[16];
#pragma unroll
  for (int r = 0; r < 16; ++r) { const int row = crow(r, hi); const float* lp = L_lds + (g * 4) * 32 + row; rli[r] = __builtin_amdgcn_rcpf((lp[0] + lp[32]) + (lp[64] + lp[96])); }
  float* Ow = Ob + (long)(g * 32) * LDO + kh * 128;
  if (MODE == 0) {
#pragma unroll
    for (int r = 0; r < 16; ++r) { const int orow = crow(r, hi);
#pragma unroll
      for (int d0 = 0; d0 < 4; ++d0) Ow[(long)orow * LDO + d0 * 32 + r32] = o[d0][r] * rli[r]; }
    asm volatile("s_waitcnt vmcnt(0)" ::: "memory"); __syncthreads();
  } else {
    float ssq[16];
#pragma unroll
    for (int r = 0; r < 16; ++r) { const int orow = crow(r, hi); float s = 0.f;
#pragma unroll
      for (int d0 = 0; d0 < 4; ++d0) { const float v = Ow[(long)orow * LDO + d0 * 32 + r32] - lam * (o[d0][r] * rli[r]); o[d0][r] = v; s += v * v; }
      s += __shfl_xor(s, 1); s += __shfl_xor(s, 2); s += __shfl_xor(s, 4); s += __shfl_xor(s, 8); s += __shfl_xor(s, 16);
      ssq[r] = s; }
    __syncthreads();
    if (r32 == 0) {
#pragma unroll
      for (int r = 0; r < 16; ++r) L_lds[wid * 32 + crow(r, hi)] = ssq[r]; }
    __syncthreads();
    constexpr float ONE_M_LI = 1.f - 0.35550906759f;
    float sw[4];
#pragma unroll
    for (int d0 = 0; d0 < 4; ++d0) sw[d0] = subw[kh * 128 + d0 * 32 + r32] * ONE_M_LI;
    char* zt = lds + wid * 8704;
#pragma unroll
    for (int r = 0; r < 16; ++r) { const int orow = crow(r, hi);
      const float rstd = rsqrtf((L_lds[wid * 32 + orow] + L_lds[(wid ^ 1) * 32 + orow]) * (1.f / 256.f) + 1e-6f);
#pragma unroll
      for (int d0 = 0; d0 < 4; ++d0) { const float z = o[d0][r] * rstd * sw[d0];
        *(unsigned short*)(zt + orow * 272 + (d0 * 32 + r32) * 2) = (unsigned short)(cvtpk(z, z) & 0xffffu); } }
    asm volatile("s_waitcnt lgkmcnt(0)" ::: "memory");
    u32x4 gq[8];
#pragma unroll
    for (int i = 0; i < 8; ++i) { const int id = lane + 64 * i; gq[i] = *(const u32x4*)(Gw + (long)(g * 32 + (id >> 4)) * 2048 + kh * 128 + (id & 15) * 8); }
#pragma unroll
    for (int i = 0; i < 8; ++i) { const int id = lane + 64 * i, row = id >> 4, cc = id & 15;
      const u32x4 zz = *(const u32x4*)(zt + row * 272 + cc * 16);
      unsigned yo[4];
#pragma unroll
      for (int k = 0; k < 4; ++k) { const unsigned zw = zz[k], gw_ = gq[i][k];
        const float z0 = __builtin_bit_cast(float, zw << 16), z1 = __builtin_bit_cast(float, zw & 0xffff0000u);
        const float g0 = __builtin_bit_cast(float, gw_ << 16), g1 = __builtin_bit_cast(float, gw_ & 0xffff0000u);
        yo[k] = cvtpk(z0 * (g0 / (1.f + __expf(-g0))), z1 * (g1 / (1.f + __expf(-g1)))); }
      *(u32x4*)(A2w + (long)(g * 32 + row) * 2048 + kh * 128 + cc * 8) = (u32x4){yo[0], yo[1], yo[2], yo[3]}; }
    asm volatile("s_waitcnt vmcnt(0)" ::: "memory"); __syncthreads();
  }
}
}
#define GAS __attribute__((address_space(1)))
#define LAS __attribute__((address_space(3)))
typedef unsigned short bf16;
typedef unsigned v4u __attribute__((ext_vector_type(4)));
typedef unsigned v2u __attribute__((ext_vector_type(2)));
typedef float f32x4 __attribute__((ext_vector_type(4)));
#define LDS_WAIT() asm volatile("s_waitcnt lgkmcnt(0)" ::: "memory")
__device__ __forceinline__ unsigned f2bf(float f) { unsigned u = __builtin_bit_cast(unsigned, f); return (u + 0x7fffu + ((u >> 16) & 1u)) >> 16; }
typedef __bf16 bf16x2_t __attribute__((ext_vector_type(2)));
typedef float f32x2_t __attribute__((ext_vector_type(2)));
__device__ __forceinline__ unsigned pk2(float lo, float hi) { const f32x2_t v = {lo, hi}; const bf16x2_t b = __builtin_convertvector(v, bf16x2_t); return __builtin_bit_cast(unsigned, b); }
__device__ __forceinline__ float bf2f(unsigned short h) { return __builtin_bit_cast(float, (unsigned)h << 16); }
__device__ __forceinline__ float bflo(unsigned w) { return __builtin_bit_cast(float, w << 16); }
__device__ __forceinline__ float bfhi(unsigned w) { return __builtin_bit_cast(float, w & 0xffff0000u); }
__device__ __forceinline__ float wave_sum(float v) {
#pragma unroll
    for (int o = 1; o < 64; o <<= 1) v += __shfl_xor(v, o);
    return v;
}
__device__ __forceinline__ float siluf(float x) { return x / (1.f + __expf(-x)); }

constexpr int DM = 2048, NB = 2, SEQ = 16384, CL = 256, TB = SEQ + CL, MT = NB * TB;
constexpr int N0 = 6144, N0P = 6400, N1 = 8192;
constexpr float EPS = 1e-6f;
constexpr float LAMBDA_INIT = 0.35550906759f;
constexpr size_t MiB = 1u << 20;
constexpr size_t WS_MODS = 0;
constexpr size_t MODS_BYTES = 2 * 3 * 6144 * 4;
constexpr size_t WS_BAR = 256 * 1024;
constexpr size_t CTL_ZERO_BYTES = WS_BAR + 3456 * 4;
constexpr size_t WS_ROPE = 512 * 1024;
constexpr size_t WS_R = 1 * MiB;
constexpr size_t WS_CTX1 = 6 * MiB;
constexpr size_t WS_WT0 = 10 * MiB, WS_WT1 = 35 * MiB, WS_WT2 = 43 * MiB, WS_WT3 = 75 * MiB;
constexpr size_t WS_H = 83 * MiB;
constexpr size_t WS_P = 213 * MiB;
constexpr size_t WS_OF = WS_H;
constexpr size_t WS_KDT = 603 * MiB;
constexpr size_t WS_PC = 733 * MiB;
constexpr size_t WS_VT = 750 * MiB;
constexpr size_t WS_OB = 880 * MiB;
constexpr size_t WS_ET = 1010 * MiB;
constexpr size_t WS_OATT = 733 * MiB;
constexpr size_t WS_END = 1015 * MiB;
constexpr int LDS_MISC = 131072, LDS_XBAR = 147456, LDS_BYTES = 147456 + 256;

struct Args { const float* in[19]; float* out; unsigned char* ws; int ph_lo, ph_hi; };
enum { I_X = 0, I_C, I_CTX, I_CCTX, I_NORMW, I_ADAW, I_ADAB, I_GWIN, I_GA1, I_GA2, I_GB, I_GGN, I_GWOUT, I_DWIN, I_DQN, I_DKN, I_DLAM, I_DSUB, I_DWOUT };

__device__ __forceinline__ void p0_transpose_item(const float* W, int K, int N, bf16* WT, int row_off, LAS float* scr, int item, int lane) {
    const int nblk = N / 32, kb = item / nblk, nb = item % nblk, k0 = 64 * kb, n0 = 32 * nb;
#pragma unroll 16
    for (int i = 0; i < 32; ++i) { const int kk = 2 * i + (lane >> 5); scr[kk * 33 + (lane & 31)] = W[(size_t)(k0 + kk) * N + n0 + (lane & 31)]; }
    LDS_WAIT(); asm volatile("" ::: "memory");
    const int c = lane & 7;
#pragma unroll
    for (int j = 0; j < 4; ++j) { const int n = (lane >> 3) + 8 * j; const LAS float* s = scr + (8 * c) * 33 + n;
        v4u o; o.x = pk2(s[0 * 33], s[1 * 33]); o.y = pk2(s[2 * 33], s[3 * 33]); o.z = pk2(s[4 * 33], s[5 * 33]); o.w = pk2(s[6 * 33], s[7 * 33]);
        *(GAS v4u*)(WT + (size_t)(row_off + n0 + n) * K + k0 + 8 * c) = o; }
    LDS_WAIT(); asm volatile("" ::: "memory");
}

__device__ __forceinline__ void ph_prologue(const Args& a, LAS unsigned char* lds) {
    const int tid = threadIdx.x, lane = tid & 63, wave = tid >> 6, G = gridDim.x;
    float* mods = (float*)(a.ws + WS_MODS);
    LAS float* sil = (LAS float*)(lds + LDS_MISC);
    for (int it = blockIdx.x; it < 768; it += G) {
        const int l = it / 384, cb = (it % 384) / 16, ks = it % 16;
        if (tid < 384) { const int cond = tid >> 7, kk = tid & 127, k = ks * 128 + kk;
            const float cv = (cond < 2) ? a.in[I_C][cond * 2048 + k] : a.in[I_CCTX][k]; sil[tid] = siluf(cv); }
        __syncthreads();
        const int col = cb * 256 + (tid & 255), kh = tid >> 8;
        const float* w = a.in[I_ADAW] + ((size_t)l * 2048 + ks * 128 + kh * 64) * 6144 + col;
        float s0 = 0.f, s1 = 0.f, s2 = 0.f;
#pragma unroll 16
        for (int kk = 0; kk < 64; ++kk) { const float wv = w[(size_t)kk * 6144]; const int q = kh * 64 + kk; s0 += sil[q] * wv; s1 += sil[128 + q] * wv; s2 += sil[256 + q] * wv; }
        if (ks == 0 && kh == 0) { const float bv = a.in[I_ADAB][l * 6144 + col]; s0 += bv; s1 += bv; s2 += bv; }
        atomicAdd(&mods[(l * 3 + 0) * 6144 + col], s0); atomicAdd(&mods[(l * 3 + 1) * 6144 + col], s1); atomicAdd(&mods[(l * 3 + 2) * 6144 + col], s2);
        __syncthreads();
    }
    bf16* WT0 = (bf16*)(a.ws + WS_WT0); bf16* WT1 = (bf16*)(a.ws + WS_WT1); bf16* WT2 = (bf16*)(a.ws + WS_WT2); bf16* WT3 = (bf16*)(a.ws + WS_WT3);
    LAS float* scr = (LAS float*)(lds + wave * 16384);
    const int gw = blockIdx.x * 8 + wave, NGW = G * 8;
    constexpr int IT0 = 32 * (N0 / 32), IT1 = 32 * 64, IT2 = 32 * (N1 / 32), IT3 = 32 * 64;
    for (int it = gw; it < IT0 + IT1 + IT2 + IT3; it += NGW) {
        int r = it;
        if (r < IT0) { p0_transpose_item(a.in[I_GWIN], 2048, N0, WT0, 0, scr, r, lane); continue; } r -= IT0;
        if (r < IT1) { p0_transpose_item(a.in[I_GWOUT], 2048, 2048, WT1, 0, scr, r, lane); continue; } r -= IT1;
        if (r < IT2) { p0_transpose_item(a.in[I_DWIN], 2048, N1, WT2, 0, scr, r, lane); continue; } r -= IT2;
        p0_transpose_item(a.in[I_DWOUT], 2048, 2048, WT3, 0, scr, r, lane);
    }
    const int gt = blockIdx.x * 512 + tid, NGT = G * 512;
    for (int idx = gt; idx < 32 * 2048; idx += NGT) { const int row = idx >> 11, k = idx & 2047, dir = row >> 4, r = row & 15;
        WT0[(size_t)(N0 + row) * 2048 + k] = (bf16)f2bf(a.in[I_GA1][((size_t)dir * 2048 + k) * 16 + r]); }
    for (int idx = gt; idx < 224 * 2048 / 8; idx += NGT) *(v4u*)(WT0 + (size_t)(N0 + 32) * 2048 + (size_t)idx * 8) = (v4u){0u, 0u, 0u, 0u};
    float* ropec = (float*)(a.ws + WS_ROPE); float* ropes = ropec + 8192;
    for (int idx = gt; idx < 8192; idx += NGT) { const int pos = idx >> 5, j = idx & 31;
        const float invf = (float)exp2(-(double)j * (1.0 / 32.0) * 13.287712379549449);
        const float ang = (float)pos * invf;
        double rev = (double)ang * 0.15915494309189535; rev -= floor(rev);
        const float rf = (float)rev;
        ropec[idx] = __builtin_amdgcn_cosf(rf); ropes[idx] = __builtin_amdgcn_sinf(rf); }
}

__device__ __forceinline__ void ph_norm(const Args& a, int layer, const float* xL, const float* xC) {
    const int lane = threadIdx.x & 63, wave = threadIdx.x >> 6; const int gw = blockIdx.x * 8 + wave, NGW = gridDim.x * 8;
    const float* mods = (const float*)(a.ws + WS_MODS) + (size_t)layer * 3 * 6144; const float* nw = a.in[I_NORMW] + layer * 2048;
    bf16* H = (bf16*)(a.ws + WS_H);
    for (int row = gw; row < MT; row += 2 * NGW) {
        const int row2 = row + NGW; const bool has2 = row2 < MT;
        const int b = row / TB, t = row % TB, b2 = has2 ? row2 / TB : b, t2 = has2 ? row2 % TB : t;
        const float* src = (t < SEQ) ? xL + ((size_t)b * SEQ + t) * 2048 : xC + ((size_t)b * CL + (t - SEQ)) * 2048;
        const float* src2 = (t2 < SEQ) ? xL + ((size_t)b2 * SEQ + t2) * 2048 : xC + ((size_t)b2 * CL + (t2 - SEQ)) * 2048;
        const float* md = mods + ((t < SEQ) ? b : 2) * 6144; const float* md2 = mods + ((t2 < SEQ) ? b2 : 2) * 6144;
        f32x4 v[8], u[8]; float ss = 0.f, ss2 = 0.f;
#pragma unroll
        for (int j = 0; j < 8; ++j) { v[j] = *(const f32x4*)(src + 256 * j + 4 * lane); u[j] = *(const f32x4*)(src2 + 256 * j + 4 * lane); }
#pragma unroll
        for (int j = 0; j < 8; ++j) { ss += (v[j].x * v[j].x + v[j].y * v[j].y) + (v[j].z * v[j].z + v[j].w * v[j].w); ss2 += (u[j].x * u[j].x + u[j].y * u[j].y) + (u[j].z * u[j].z + u[j].w * u[j].w); }
        const float rstd = rsqrtf(wave_sum(ss) * (1.f / 2048.f) + EPS), rstd2 = rsqrtf(wave_sum(ss2) * (1.f / 2048.f) + EPS);
#pragma unroll
        for (int j = 0; j < 8; ++j) { const int c = 256 * j + 4 * lane;
            const f32x4 w4 = *(const f32x4*)(nw + c);
            { const f32x4 sh = *(const f32x4*)(md + c), sc = *(const f32x4*)(md + 2048 + c); const f32x4 y = (v[j] * rstd) * w4 * (sc + 1.f) + sh;
              *(v2u*)(H + (size_t)row * 2048 + c) = (v2u){pk2(y.x, y.y), pk2(y.z, y.w)}; }
            if (has2) { const f32x4 sh = *(const f32x4*)(md2 + c), sc = *(const f32x4*)(md2 + 2048 + c); const f32x4 y = (u[j] * rstd2) * w4 * (sc + 1.f) + sh;
              *(v2u*)(H + (size_t)row2 * 2048 + c) = (v2u){pk2(y.x, y.y), pk2(y.z, y.w)}; } }
    }
}

__device__ __forceinline__ int gla_row(int b, int dir, int n) {
    int t; if (n < CL) t = SEQ + (dir ? (CL - 1 - n) : n); else { const int m = n - CL; t = dir ? (SEQ - 1 - m) : m; }
    return b * TB + t;
}
__device__ __forceinline__ void ph_gla_naive(const Args& a, LAS unsigned char* lds) {
    const int tid = threadIdx.x;
    const bf16* P = (const bf16*)(a.ws + WS_P); const float* R = (const float*)(a.ws + WS_R);
    LAS float* bufE = (LAS float*)lds;
    LAS float* bufK = bufE + 2 * 16 * 256;
    LAS float* bufQ = bufK + 2 * 16 * 256;
    LAS float* bufV = bufQ + 2 * 16 * 256;
    for (int item = blockIdx.x; item < 256; item += gridDim.x) {
        const int chain = item >> 4, eb = item & 15, b = chain >> 3, h = (chain >> 1) & 3, dir = chain & 1;
        bf16* O = (bf16*)(a.ws + (dir ? WS_OB : WS_OF));
        const int e = tid >> 4, ds = tid & 15, dp = tid & 255, tp = tid >> 8;
        float a2c[16];
#pragma unroll
        for (int r = 0; r < 16; ++r) a2c[r] = a.in[I_GA2][(size_t)(dir * 16 + r) * 1024 + h * 256 + dp];
        const float gbv = a.in[I_GB][dir * 1024 + h * 256 + dp];
        float s[16];
#pragma unroll
        for (int i = 0; i < 16; ++i) s[i] = 0.f;
#define GLA_PREP(bt, buf) do { \
        _Pragma("unroll") for (int j = 0; j < 8; ++j) { const int tk = tp + 2 * j; const int row = gla_row(b, dir, (bt) * 16 + tk); \
            const float* rr = R + (size_t)row * 32 + dir * 16; float g = gbv; \
            _Pragma("unroll") for (int r = 0; r < 16; ++r) g += rr[r] * a2c[r]; \
            const float ls = fminf(g, 0.f) - __logf(1.f + __expf(-fabsf(g))); \
            bufE[((buf) * 16 + tk) * 256 + dp] = __expf(ls * (1.f / 16.f)); \
            bufQ[((buf) * 16 + tk) * 256 + dp] = bf2f(P[(size_t)row * N0 + h * 256 + dp]); \
            bufK[((buf) * 16 + tk) * 256 + dp] = bf2f(P[(size_t)row * N0 + 1024 + h * 256 + dp]); } \
        { const int tk = tid >> 5, ee = tid & 31; const int row = gla_row(b, dir, (bt) * 16 + tk); \
            bufV[((buf) * 16 + tk) * 32 + ee] = bf2f(P[(size_t)row * N0 + 2048 + h * 512 + eb * 32 + ee]); } } while (0)
        __syncthreads();
        GLA_PREP(0, 0);
        __syncthreads();
        constexpr int NBT = TB / 16;
        for (int bt = 0; bt < NBT; ++bt) {
            const int cur = bt & 1;
            if (bt + 1 < NBT) GLA_PREP(bt + 1, cur ^ 1);
            for (int tk = 0; tk < 16; ++tk) {
                const float v = bufV[(cur * 16 + tk) * 32 + e]; float acc = 0.f;
#pragma unroll
                for (int i = 0; i < 4; ++i) {
                    const f32x4 e4 = *(const LAS f32x4*)(bufE + (cur * 16 + tk) * 256 + i * 64 + ds * 4);
                    const f32x4 k4 = *(const LAS f32x4*)(bufK + (cur * 16 + tk) * 256 + i * 64 + ds * 4);
                    const f32x4 q4 = *(const LAS f32x4*)(bufQ + (cur * 16 + tk) * 256 + i * 64 + ds * 4);
                    s[4 * i + 0] = e4.x * s[4 * i + 0] + k4.x * v; acc += q4.x * s[4 * i + 0];
                    s[4 * i + 1] = e4.y * s[4 * i + 1] + k4.y * v; acc += q4.y * s[4 * i + 1];
                    s[4 * i + 2] = e4.z * s[4 * i + 2] + k4.z * v; acc += q4.z * s[4 * i + 2];
                    s[4 * i + 3] = e4.w * s[4 * i + 3] + k4.w * v; acc += q4.w * s[4 * i + 3];
                }
                acc += __shfl_xor(acc, 1); acc += __shfl_xor(acc, 2); acc += __shfl_xor(acc, 4); acc += __shfl_xor(acc, 8);
                if (ds == 0) { const int row = gla_row(b, dir, bt * 16 + tk); O[(size_t)row * 2048 + h * 512 + eb * 32 + e] = (bf16)f2bf(acc); }
            }
            __syncthreads();
        }
#undef GLA_PREP
    }
}


typedef short bf16x8_t __attribute__((ext_vector_type(8)));
typedef float f32x16_t __attribute__((ext_vector_type(16)));
__device__ __forceinline__ float logsig16(float g) { return (fminf(g, 0.f) - __logf(1.f + __expf(-fabsf(g)))) * (1.f / 16.f); }
__device__ __forceinline__ void ph_gla_pre(const Args& a, LAS unsigned char* lds) {
    const int tid = threadIdx.x, lane = tid & 63, wave = tid >> 6;
    bf16* P = (bf16*)(a.ws + WS_P); const float* R = (const float*)(a.ws + WS_R);
    bf16* KDT = (bf16*)(a.ws + WS_KDT); bf16* PC = (bf16*)(a.ws + WS_PC); bf16* VT = (bf16*)(a.ws + WS_VT); float* ET = (float*)(a.ws + WS_ET);
    LAS float* Rt = (LAS float*)(lds + 131072); LAS float* PcT = (LAS float*)(lds + 131072);
    for (int item = blockIdx.x; item < 2080; item += gridDim.x) {
        const int bh = item / 260, c = item % 260, b = bh >> 2, h = bh & 3;
        const size_t row0 = (size_t)b * TB + (size_t)c * 64;
#pragma unroll
        for (int j = 0; j < 8; ++j) { const int piece = tid + 512 * j, r = piece >> 6, cc = piece & 63;
            *(LAS v4u*)(lds + r * 1040 + cc * 16) = *(const v4u*)(P + (row0 + r) * N0 + 2048 + h * 512 + cc * 8); }
        __syncthreads();
        { bf16* vrow = VT + ((size_t)item * 512 + tid) * 64;
#pragma unroll
          for (int g8 = 0; g8 < 8; ++g8) { unsigned w[4];
#pragma unroll
            for (int q = 0; q < 4; ++q) { const unsigned lo = *(const LAS unsigned short*)(lds + (g8 * 8 + 2 * q) * 1040 + tid * 2), hi = *(const LAS unsigned short*)(lds + (g8 * 8 + 2 * q + 1) * 1040 + tid * 2); w[q] = lo | (hi << 16); }
            *(v4u*)(vrow + g8 * 8) = (v4u){w[0], w[1], w[2], w[3]}; } }
        { const int r = tid >> 3, q4 = tid & 7; *(LAS f32x4*)(lds + 131072 + tid * 16) = *(const f32x4*)(R + (row0 + r) * 32 + q4 * 4); }
        __syncthreads();
        {
            const int d = tid & 255, dir = tid >> 8;
            float a2c[16];
#pragma unroll
            for (int r = 0; r < 16; ++r) a2c[r] = a.in[I_GA2][(size_t)(dir * 16 + r) * 1024 + h * 256 + d];
            const float gbv = a.in[I_GB][dir * 1024 + h * 256 + d];
            float bc = 0.f;
            LAS unsigned char* qe_t = lds + dir * 32768; LAS unsigned char* ki_t = lds + 65536 + dir * 32768;
            bf16* kdrow = KDT + ((((size_t)(dir * 2 + b) * 4 + h) * 260 + c) * 256 + d) * 64;
            unsigned short qn[8], kn[8];
#pragma unroll
            for (int jj = 0; jj < 8; ++jj) { const int i = dir ? 63 - jj : jj; qn[jj] = P[(row0 + i) * N0 + h * 256 + d]; kn[jj] = P[(row0 + i) * N0 + 1024 + h * 256 + d]; }
            for (int ib = 0; ib < 8; ++ib) {
                float kdv[8]; unsigned short qc[8], kc[8];
#pragma unroll
                for (int jj = 0; jj < 8; ++jj) { qc[jj] = qn[jj]; kc[jj] = kn[jj]; }
                if (ib < 7) {
#pragma unroll
                    for (int jj = 0; jj < 8; ++jj) { const int ii = (ib + 1) * 8 + jj, i = dir ? 63 - ii : ii; qn[jj] = P[(row0 + i) * N0 + h * 256 + d]; kn[jj] = P[(row0 + i) * N0 + 1024 + h * 256 + d]; } }
#pragma unroll
                for (int jj = 0; jj < 8; ++jj) { const int ii = ib * 8 + jj, i = dir ? 63 - ii : ii;
                    const LAS f32x4* rp = (const LAS f32x4*)(Rt + i * 32 + dir * 16);
                    const f32x4 r0 = rp[0], r1 = rp[1], r2 = rp[2], r3 = rp[3];
                    float g = gbv;
                    g += r0.x * a2c[0] + r0.y * a2c[1] + r0.z * a2c[2] + r0.w * a2c[3];
                    g += r1.x * a2c[4] + r1.y * a2c[5] + r1.z * a2c[6] + r1.w * a2c[7];
                    g += r2.x * a2c[8] + r2.y * a2c[9] + r2.z * a2c[10] + r2.w * a2c[11];
                    g += r3.x * a2c[12] + r3.y * a2c[13] + r3.z * a2c[14] + r3.w * a2c[15];
                    bc += logsig16(g);
                    const float q = bf2f(qc[jj]), k = bf2f(kc[jj]);
                    const float ex = __expf(bc), em = __expf(fminf(-bc, 80.f));
                    const int so = i * 512 + (((d >> 3) ^ (i & 15)) << 4) + (d & 7) * 2;
                    *(LAS unsigned short*)(qe_t + so) = (unsigned short)f2bf(q * ex);
                    *(LAS unsigned short*)(ki_t + so) = (unsigned short)f2bf(k * em);
                    kdv[jj] = k * em; }
                v4u w;
                if (dir == 0) w = (v4u){pk2(kdv[0], kdv[1]), pk2(kdv[2], kdv[3]), pk2(kdv[4], kdv[5]), pk2(kdv[6], kdv[7])};
                else          w = (v4u){pk2(kdv[7], kdv[6]), pk2(kdv[5], kdv[4]), pk2(kdv[3], kdv[2]), pk2(kdv[1], kdv[0])};
                const int tok0 = dir ? 56 - ib * 8 : ib * 8;
                *(v4u*)(kdrow + tok0) = w;
            }
            ET[(((size_t)(dir * 2 + b) * 4 + h) * 260 + c) * 256 + d] = __expf(bc);
        }
        __syncthreads();
#pragma unroll
        for (int j = 0; j < 8; ++j) { const int ch = tid + 512 * j, dirq = ch >> 11, rem = ch & 2047, i = rem >> 5, oc = rem & 31, pg = oc >> 2, kgq = oc & 3;
            const int c1 = 4 * pg + (kgq >> 1), half = kgq & 1;
            const v2u lo = *(const LAS v2u*)(lds + dirq * 32768 + i * 512 + ((c1 ^ (i & 15)) << 4) + half * 8);
            const v2u hi = *(const LAS v2u*)(lds + dirq * 32768 + i * 512 + (((c1 + 2) ^ (i & 15)) << 4) + half * 8);
            *(v4u*)(P + (row0 + i) * N0 + dirq * 1024 + h * 256 + oc * 8) = (v4u){lo.x, lo.y, hi.x, hi.y}; }
        const int dirw = wave >> 2, ib2 = (wave >> 1) & 1, jb2 = wave & 1, r32 = lane & 31, hi2 = lane >> 5;
        const bool skip = (dirw == 0) ? (ib2 == 0 && jb2 == 1) : (ib2 == 1 && jb2 == 0);
        f32x16_t accP = {};
        if (!skip) {
            const int jr = 32 * jb2 + r32, ir = 32 * ib2 + r32;
#pragma unroll
            for (int ks = 0; ks < 16; ++ks) { const int chk = ks * 2 + hi2;
                const bf16x8_t af = *(const LAS bf16x8_t*)(lds + 65536 + dirw * 32768 + jr * 512 + ((chk ^ (jr & 15)) << 4));
                const bf16x8_t bf = *(const LAS bf16x8_t*)(lds + dirw * 32768 + ir * 512 + ((chk ^ (ir & 15)) << 4));
                accP = __builtin_amdgcn_mfma_f32_32x32x16_bf16(af, bf, accP, 0, 0, 0); }
        }
        {   const int iq = 32 * ib2 + r32;
#pragma unroll
            for (int r = 0; r < 16; ++r) { const int jq = 32 * jb2 + (r & 3) + 8 * (r >> 2) + 4 * hi2; const bool keep = (dirw == 0) ? (jq <= iq) : (jq >= iq); accP[r] = (keep && !skip) ? accP[r] : 0.f; }
            __syncthreads();
            if (dirw == 0) {
#pragma unroll
                for (int g4 = 0; g4 < 4; ++g4) *(LAS f32x4*)(PcT + iq * 64 + 32 * jb2 + 8 * g4 + 4 * hi2) = (f32x4){accP[4 * g4], accP[4 * g4 + 1], accP[4 * g4 + 2], accP[4 * g4 + 3]};
            }
            __syncthreads();
            if (dirw == 1 && !skip) {
#pragma unroll
                for (int g4 = 0; g4 < 4; ++g4) { LAS f32x4* pp = (LAS f32x4*)(PcT + iq * 64 + 32 * jb2 + 8 * g4 + 4 * hi2); *pp = *pp + (f32x4){accP[4 * g4], accP[4 * g4 + 1], accP[4 * g4 + 2], accP[4 * g4 + 3]}; }
            }
            __syncthreads();
        }
        { const int i = tid >> 3, j0 = (tid & 7) * 8; const f32x4 x0 = *(const LAS f32x4*)(PcT + i * 64 + j0), x1 = *(const LAS f32x4*)(PcT + i * 64 + j0 + 4);
          *(v4u*)(PC + ((size_t)item * 64 + i) * 64 + j0) = (v4u){pk2(x0.x, x0.y), pk2(x0.z, x0.w), pk2(x1.x, x1.y), pk2(x1.z, x1.w)}; }
        __syncthreads();
    }
}

__device__ __forceinline__ void ph_gla_scan(const Args& a, LAS unsigned char* lds) {
    const int tid = threadIdx.x, lane = tid & 63, wave = __builtin_amdgcn_readfirstlane(tid >> 6), l16 = lane & 15, kg = lane >> 4;
    const bf16* P = (const bf16*)(a.ws + WS_P);
    const bf16* KDT = (const bf16*)(a.ws + WS_KDT); const bf16* PC = (const bf16*)(a.ws + WS_PC); const bf16* VT = (const bf16*)(a.ws + WS_VT); const float* ET = (const float*)(a.ws + WS_ET);
    constexpr int QS = 528, RS = 144, L_K = 33792, L_V = 70656, L_P = 79872, L_E = 89088;
    for (int it_ = blockIdx.x; it_ < 128 || (gridDim.x == 256 && it_ < 256); it_ += gridDim.x) {
        int item = it_;
        if (gridDim.x == 256) { const int x_ = it_ & 7, sl_ = it_ >> 3; if (sl_ >= 16) break; item = ((x_ * 2 + (sl_ >> 3)) << 3) | (sl_ & 7); }
        const int chain = item >> 3, dvb = item & 7, b = chain >> 3, h = (chain >> 1) & 3, dir = chain & 1, bh = b * 4 + h;
#define GS_CHUNK(n) (dir ? 259 - (n) : ((n) < 4 ? 256 + (n) : (n) - 4))
        if (wave >= 4) {
            const int ht = tid - 256;
            v4u Qa[12], Qb[12], Ka[9], Kb[9];
#define GS_LOADQ(S, n) do { const int c_ = GS_CHUNK(n); const size_t row0_ = (size_t)b * TB + (size_t)c_ * 64; \
            _Pragma("unroll") for (int j = 0; j < 8; ++j) { const int piece = ht + 256 * j; S[j] = *(const v4u*)(P + (row0_ + (piece >> 5)) * N0 + dir * 1024 + h * 256 + (piece & 31) * 8); } \
            const bf16* vb_ = VT + (((size_t)bh * 260 + c_) * 512 + dvb * 64) * 64; \
            _Pragma("unroll") for (int j = 0; j < 2; ++j) S[8 + j] = *(const v4u*)(vb_ + (size_t)(ht + 256 * j) * 8); \
            if (dir == 0) { _Pragma("unroll") for (int j = 0; j < 2; ++j) S[10 + j] = *(const v4u*)(PC + ((size_t)bh * 260 + c_) * 4096 + (size_t)(ht + 256 * j) * 8); } } while (0)
#define GS_LOADK(S, n) do { const int c_ = GS_CHUNK(n); \
            const bf16* kb_ = KDT + ((((size_t)(dir * 2 + b) * 4 + h) * 260 + c_) * 256) * 64; \
            _Pragma("unroll") for (int j = 0; j < 8; ++j) S[j] = *(const v4u*)(kb_ + (size_t)(ht + 256 * j) * 8); \
            if (ht < 64) S[8] = *(const v4u*)(ET + (((size_t)(dir * 2 + b) * 4 + h) * 260 + c_) * 256 + ht * 4); } while (0)
#define GS_WRITEQ(S) do { \
            _Pragma("unroll") for (int j = 0; j < 8; ++j) { const int piece = ht + 256 * j; *(LAS v4u*)(lds + (piece >> 5) * QS + (piece & 31) * 16) = S[j]; } \
            _Pragma("unroll") for (int j = 0; j < 2; ++j) { const int piece = ht + 256 * j; *(LAS v4u*)(lds + L_V + (piece >> 3) * RS + (piece & 7) * 16) = S[8 + j]; } \
            if (dir == 0) { _Pragma("unroll") for (int j = 0; j < 2; ++j) { const int piece = ht + 256 * j; *(LAS v4u*)(lds + L_P + (piece >> 3) * RS + (piece & 7) * 16) = S[10 + j]; } } } while (0)
#define GS_WRITEK(S) do { \
            _Pragma("unroll") for (int j = 0; j < 8; ++j) { const int piece = ht + 256 * j; *(LAS v4u*)(lds + L_K + (piece >> 3) * RS + (piece & 7) * 16) = S[j]; } \
            if (ht < 64) *(LAS v4u*)(lds + L_E + ht * 16) = S[8]; } while (0)
#pragma unroll
            for (int j = 0; j < 12; ++j) { Qa[j] = (v4u){0u, 0u, 0u, 0u}; Qb[j] = (v4u){0u, 0u, 0u, 0u}; }
#pragma unroll
            for (int j = 0; j < 9; ++j) { Ka[j] = (v4u){0u, 0u, 0u, 0u}; Kb[j] = (v4u){0u, 0u, 0u, 0u}; }
            GS_LOADQ(Qa, 0); GS_LOADK(Ka, 0); GS_LOADQ(Qb, 1); GS_LOADK(Kb, 1);
            GS_WRITEQ(Qa); GS_LOADQ(Qa, 2);
            __syncthreads();
            for (int n = 0; n < 260; n += 2) {
                __syncthreads(); GS_WRITEK(Ka); if (n + 2 < 260) GS_LOADK(Ka, n + 2);
                __syncthreads(); GS_WRITEQ(Qb); if (n + 3 < 260) GS_LOADQ(Qb, n + 3);
                __syncthreads(); GS_WRITEK(Kb); if (n + 3 < 260) GS_LOADK(Kb, n + 3);
                __syncthreads(); if (n + 2 < 260) { GS_WRITEQ(Qa); } if (n + 4 < 260) GS_LOADQ(Qa, n + 4);
            }
#undef GS_LOADQ
#undef GS_LOADK
#undef GS_WRITEQ
#undef GS_WRITEK
        } else {
            bf16* O = (bf16*)(a.ws + (dir ? WS_OB : WS_OF));
            f32x4 s[16];
#pragma unroll
            for (int t = 0; t < 16; ++t) s[t] = (f32x4){0.f, 0.f, 0.f, 0.f};
            __syncthreads();
            for (int n = 0; n < 260; ++n) {
                __syncthreads();
                const int ccur = GS_CHUNK(n); const size_t row0 = (size_t)b * TB + (size_t)ccur * 64;
                bf16x8_t sa[8];
#pragma unroll
                for (int p = 0; p < 8; ++p) { const v4u w = {pk2(s[2 * p][0], s[2 * p][1]), pk2(s[2 * p][2], s[2 * p][3]), pk2(s[2 * p + 1][0], s[2 * p + 1][1]), pk2(s[2 * p + 1][2], s[2 * p + 1][3])}; sa[p] = __builtin_bit_cast(bf16x8_t, w); }
                const LAS unsigned char* vrow = lds + L_V + (16 * wave + l16) * RS + kg * 16;
                const bf16x8_t vt0 = *(const LAS bf16x8_t*)(vrow), vt1 = *(const LAS bf16x8_t*)(vrow + 64);
                const LAS unsigned char* qrow = lds + l16 * QS + kg * 16; const LAS unsigned char* prow = lds + L_P + l16 * RS + kg * 16;
                f32x4 o4[4];
#pragma unroll
                for (int tt = 0; tt < 4; ++tt) o4[tt] = (f32x4){0.f, 0.f, 0.f, 0.f};
#pragma unroll
                for (int p = 0; p < 8; ++p) {
#pragma unroll
                    for (int tt = 0; tt < 4; ++tt) { const bf16x8_t qb = *(const LAS bf16x8_t*)(qrow + tt * 16 * QS + p * 64); o4[tt] = __builtin_amdgcn_mfma_f32_16x16x32_bf16(sa[p], qb, o4[tt], 0, 0, 0); } }
                if (dir == 0) {
#pragma unroll
                    for (int tt = 0; tt < 4; ++tt) { const bf16x8_t pb0 = *(const LAS bf16x8_t*)(prow + tt * 16 * RS); o4[tt] = __builtin_amdgcn_mfma_f32_16x16x32_bf16(vt0, pb0, o4[tt], 0, 0, 0); }
#pragma unroll
                    for (int tt = 0; tt < 4; ++tt) { const bf16x8_t pb1 = *(const LAS bf16x8_t*)(prow + tt * 16 * RS + 64); o4[tt] = __builtin_amdgcn_mfma_f32_16x16x32_bf16(vt1, pb1, o4[tt], 0, 0, 0); } }
#pragma unroll
                for (int tt = 0; tt < 4; ++tt) *(v2u*)(O + (row0 + 16 * tt + l16) * 2048 + h * 512 + dvb * 64 + 16 * wave + 4 * kg) = (v2u){pk2(o4[tt][0], o4[tt][1]), pk2(o4[tt][2], o4[tt][3])};
                __syncthreads();
                const LAS unsigned char* krow = lds + L_K + l16 * RS + kg * 16; const LAS unsigned char* erow = lds + L_E + kg * 16;
#pragma unroll
                for (int t = 0; t < 16; ++t) { const bf16x8_t ka0 = *(const LAS bf16x8_t*)(krow + t * 16 * RS); s[t] = __builtin_amdgcn_mfma_f32_16x16x32_bf16(ka0, vt0, s[t], 0, 0, 0); }
#pragma unroll
                for (int t = 0; t < 16; ++t) { const bf16x8_t ka1 = *(const LAS bf16x8_t*)(krow + t * 16 * RS + 64); s[t] = __builtin_amdgcn_mfma_f32_16x16x32_bf16(ka1, vt1, s[t], 0, 0, 0); }
#pragma unroll
                for (int t = 0; t < 16; ++t) { const f32x4 et = *(const LAS f32x4*)(erow + t * 64); s[t] = s[t] * et; }
            }
        }
#undef GS_CHUNK
        __syncthreads();
    }
}

__device__ __forceinline__ void ph_gla_finish(const Args& a) {
    const int lane = threadIdx.x & 63, wave = threadIdx.x >> 6; const int gw = blockIdx.x * 8 + wave, NGW = gridDim.x * 8;
    const bf16* P = (const bf16*)(a.ws + WS_P); const bf16* OF = (const bf16*)(a.ws + WS_OF); const bf16* OB = (const bf16*)(a.ws + WS_OB);
    bf16* A2 = (bf16*)(a.ws + WS_H);
    float gn[8];
#pragma unroll
    for (int i = 0; i < 8; ++i) gn[i] = a.in[I_GGN][lane * 8 + i];
    for (int row = gw; row < MT; row += NGW) {
        v4u f[4], bb[4], gg[4];
#pragma unroll
        for (int h = 0; h < 4; ++h) { const size_t off = (size_t)row * 2048 + h * 512 + lane * 8;
            f[h] = *(const v4u*)(OF + off); bb[h] = *(const v4u*)(OB + off); gg[h] = *(const v4u*)(P + (size_t)row * N0 + 4096 + h * 512 + lane * 8); }
#pragma unroll
        for (int h = 0; h < 4; ++h) {
            float o[8], g[8];
            o[0] = bflo(f[h].x) + bflo(bb[h].x); o[1] = bfhi(f[h].x) + bfhi(bb[h].x); o[2] = bflo(f[h].y) + bflo(bb[h].y); o[3] = bfhi(f[h].y) + bfhi(bb[h].y);
            o[4] = bflo(f[h].z) + bflo(bb[h].z); o[5] = bfhi(f[h].z) + bfhi(bb[h].z); o[6] = bflo(f[h].w) + bflo(bb[h].w); o[7] = bfhi(f[h].w) + bfhi(bb[h].w);
            g[0] = bflo(gg[h].x); g[1] = bfhi(gg[h].x); g[2] = bflo(gg[h].y); g[3] = bfhi(gg[h].y); g[4] = bflo(gg[h].z); g[5] = bfhi(gg[h].z); g[6] = bflo(gg[h].w); g[7] = bfhi(gg[h].w);
            float ss = 0.f;
#pragma unroll
            for (int i = 0; i < 8; ++i) ss += o[i] * o[i];
            const float rstd = rsqrtf(wave_sum(ss) * (1.f / 512.f) + EPS);
            float y[8];
#pragma unroll
            for (int i = 0; i < 8; ++i) y[i] = o[i] * rstd * gn[i] * siluf(g[i]);
            *(v4u*)(A2 + (size_t)row * 2048 + h * 512 + lane * 8) = (v4u){pk2(y[0], y[1]), pk2(y[2], y[3]), pk2(y[4], y[5]), pk2(y[6], y[7])};
        }
    }
}

__device__ __forceinline__ float sum16(float v) { v += __shfl_xor(v, 1); v += __shfl_xor(v, 2); v += __shfl_xor(v, 4); v += __shfl_xor(v, 8); return v; }
__device__ __forceinline__ v4u qk_chunk(v4u x, const float* w8, const float* c8, const float* s8, bool lat, float sg) {
    float v[8] = {bflo(x.x), bfhi(x.x), bflo(x.y), bfhi(x.y), bflo(x.z), bfhi(x.z), bflo(x.w), bfhi(x.w)};
    float ss = 0.f;
#pragma unroll
    for (int i = 0; i < 8; ++i) ss += v[i] * v[i];
    const float rstd = rsqrtf(sum16(ss) * (1.f / 128.f) + EPS);
#pragma unroll
    for (int i = 0; i < 8; ++i) v[i] = v[i] * rstd * w8[i];
    if (lat) {
#pragma unroll
        for (int i = 0; i < 8; ++i) { const float pv = __shfl_xor(v[i], 4); v[i] = v[i] * c8[i] + sg * pv * s8[i]; }
    }
    return (v4u){pk2(v[0], v[1]), pk2(v[2], v[3]), pk2(v[4], v[5]), pk2(v[6], v[7])};
}
__device__ __forceinline__ void ph_qk_post(const Args& a) {
    const int lane = threadIdx.x & 63, wave = threadIdx.x >> 6; const int gw = blockIdx.x * 8 + wave, NGW = gridDim.x * 8;
    bf16* QD = (bf16*)(a.ws + WS_P); bf16* KD = (bf16*)(a.ws + WS_P + 130 * MiB);
    const float* ropec = (const float*)(a.ws + WS_ROPE); const float* ropes = ropec + 8192;
    const int l16 = lane & 15;
    const float sg = (l16 & 4) ? 1.f : -1.f;
    for (int item = gw; item < 2 * 32 * 1040; item += NGW) {
        const int which = item / (32 * 1040), rem = item % (32 * 1040), blk = rem / 1040, it = rem % 1040, m = blk & 1;
        if (which == 0 && it >= 1024) continue;
        bf16* base = (which ? KD : QD) + ((size_t)blk * TB + (size_t)it * 16) * 128 + lane * 8;
        const float* wsrc = (which ? a.in[I_DKN] : a.in[I_DQN]) + m * 128 + l16 * 8;
        float w8[8];
#pragma unroll
        for (int i = 0; i < 8; ++i) w8[i] = wsrc[i];
        v4u x[4];
#pragma unroll
        for (int j = 0; j < 4; ++j) x[j] = *(const v4u*)(base + j * 512);
        const bool lat = it < 1024;
#pragma unroll
        for (int j = 0; j < 4; ++j) {
            float c8[8], s8[8];
            if (lat) { const int t = it * 16 + 4 * j + (lane >> 4); const int pos = (l16 & 8) ? (t & 63) : (t >> 6);
                const float* cp = ropec + pos * 32 + (l16 & 3) * 8; const float* sp = ropes + pos * 32 + (l16 & 3) * 8;
#pragma unroll
                for (int i = 0; i < 8; ++i) { c8[i] = cp[i]; s8[i] = sp[i]; } }
            else {
#pragma unroll
                for (int i = 0; i < 8; ++i) { c8[i] = 1.f; s8[i] = 0.f; } }
            *(v4u*)(base + j * 512) = qk_chunk(x[j], w8, c8, s8, lat, sg);
        }
    }
}

__device__ __forceinline__ void ph_attn(const Args& a, unsigned char* lds) {
    const float* lv = a.in[I_DLAM];
    float d01 = 0.f, d23 = 0.f;
    for (int i = 0; i < 128; ++i) { d01 += lv[i] * lv[128 + i]; d23 += lv[256 + i] * lv[384 + i]; }
    const float lam = __expf(d01) - __expf(d23) + LAMBDA_INIT;
    float wq = 0.f, wk = 0.f;
    for (int i = 0; i < 256; ++i) { wq = fmaxf(wq, fabsf(a.in[I_DQN][i])); wk = fmaxf(wk, fabsf(a.in[I_DKN][i])); }
    const float negMc = -(attn::SCALE * 128.f * wq * wk) * 1.4426950408889634f;
    const attn::bf16* P = (const attn::bf16*)(a.ws + WS_P); float* OA = (float*)(a.ws + WS_OATT);
    const int G = gridDim.x, c = blockIdx.x;
    for (int rr = 0;; ++rr) {
        int combo, qb;
        if (G == 256) { if (rr >= 8) break; const int xs = rr * 8 + (c & 7); combo = xs >> 2; qb = (xs & 3) * 32 + (c >> 3); }
        else { const int id = rr * G + c; if (id >= 2048) break; combo = id >> 7; qb = id & 127; }
        const int b = combo >> 3, h = combo & 7;
        const attn::bf16* Q0 = P + (((size_t)(b * 8 + h) * 2) * TB + (size_t)qb * 128) * 128;
        const attn::bf16* K0 = P + (size_t)130 * MiB / 2 + ((size_t)(b * 8 + h) * 2) * TB * 128;
        const attn::bf16* V0 = P + (size_t)260 * MiB / 2 + (size_t)(b * 8 + h) * TB * 256;
        const size_t row0 = (size_t)b * TB + (size_t)qb * 128;
        unsigned short* A2w = (unsigned short*)(a.ws + WS_H) + row0 * 2048 + h * 256;
        const unsigned short* Gw = (const unsigned short*)(a.ws + WS_P + (size_t)390 * MiB) + row0 * 2048 + h * 256;
        float* O = OA + ((size_t)b * SEQ + (size_t)qb * 128) * 2048 + h * 256;
        attn::attn_ks_body<0>(Q0, K0, V0, O, A2w, Gw, a.in[I_DSUB], TB, (char*)lds, lam, negMc);
        attn::attn_ks_body<1>(Q0 + (size_t)TB * 128, K0 + (size_t)TB * 128, V0, O, A2w, Gw, a.in[I_DSUB], TB, (char*)lds, lam, negMc);
    }
}

__device__ __forceinline__ void ph_diff_finish(const Args& a) {
    const int lane = threadIdx.x & 63, wave = threadIdx.x >> 6; const int gw = blockIdx.x * 8 + wave, NGW = gridDim.x * 8;
    const bf16* P = (const bf16*)(a.ws + WS_P); const float* OA = (const float*)(a.ws + WS_OATT); bf16* A2 = (bf16*)(a.ws + WS_H);
    const f32x4 w4 = *(const f32x4*)(a.in[I_DSUB] + lane * 4);
    for (int lr = gw; lr < NB * SEQ; lr += NGW) {
        const int b = lr / SEQ, t = lr % SEQ; const size_t row = (size_t)b * TB + t;
        f32x4 o[8]; v2u gg[8];
#pragma unroll
        for (int h = 0; h < 8; ++h) { o[h] = *(const f32x4*)(OA + (size_t)lr * 2048 + h * 256 + lane * 4); gg[h] = *(const v2u*)(P + (size_t)390 * MiB / 2 + row * 2048 + h * 256 + lane * 4); }
#pragma unroll
        for (int h = 0; h < 8; ++h) {
            const float rstd = rsqrtf(wave_sum((o[h].x * o[h].x + o[h].y * o[h].y) + (o[h].z * o[h].z + o[h].w * o[h].w)) * (1.f / 256.f) + EPS) * (1.f - LAMBDA_INIT);
            const float y0 = o[h].x * rstd * w4.x * siluf(bflo(gg[h].x)), y1 = o[h].y * rstd * w4.y * siluf(bfhi(gg[h].x)), y2 = o[h].z * rstd * w4.z * siluf(bflo(gg[h].y)), y3 = o[h].w * rstd * w4.w * siluf(bfhi(gg[h].y));
            *(v2u*)(A2 + row * 2048 + h * 256 + lane * 4) = (v2u){pk2(y0, y1), pk2(y2, y3)};
        }
    }
}

#define XB_TMO      128
#define XB_XCNT(j)  (256  + 64 * (j))
#define XB_XSUB(j)  (1280 + 64 * (j))
#define XB_XGEN(j)  (2304 + 64 * (j))
#define XB_TOP      3328
#define XB_TOPGEN   3392
#define XCD_BAR_WORDS 3456
#define XB_SPIN_CAP (1u << 18)

__device__ __forceinline__ unsigned xb_ld(unsigned* p)              { return __hip_atomic_load(p, __ATOMIC_RELAXED, __HIP_MEMORY_SCOPE_AGENT); }
__device__ __forceinline__ unsigned xb_add(unsigned* p, unsigned v) { return __hip_atomic_fetch_add(p, v, __ATOMIC_RELAXED, __HIP_MEMORY_SCOPE_AGENT); }
__device__ __forceinline__ unsigned xb_xcc_id() { return (unsigned)__builtin_amdgcn_s_getreg((3 << 11) | 20) & 0xFu; }
#define XB_SPIN(cond, bar) do { unsigned _sp = 0; while (cond) { __builtin_amdgcn_s_sleep(1); \
    if ((++_sp & 255u) == 0u) { if (xb_ld(&(bar)[XB_TMO])) break; if (_sp > XB_SPIN_CAP) { atomicAdd(&(bar)[XB_TMO], 1u); break; } } } } while (0)

struct XcdBarrier {
    unsigned* bar; unsigned x;
    volatile LAS unsigned* st;
};

__device__ __forceinline__ XcdBarrier xcd_barrier_post(unsigned* bar, volatile LAS unsigned* st) {
    XcdBarrier b; b.bar = bar; b.x = xb_xcc_id(); b.st = st;
    if (threadIdx.x == 0) (void)xb_add(&bar[XB_XCNT(b.x)], 1u);
    return b;
}
__device__ __forceinline__ void xcd_barrier_complete(unsigned* bar, unsigned x, unsigned& nloc, unsigned& nx) {
    const unsigned G = gridDim.x * gridDim.y * gridDim.z;
    unsigned sum, cnt, mine, sp = 0u;
    for (;;) {
        sum = 0u; cnt = 0u; mine = 0u;
#pragma unroll
        for (unsigned j = 0; j < 16; ++j) { const unsigned c = xb_ld(&bar[XB_XCNT(j)]); sum += c; cnt += (c > 0u) ? 1u : 0u; mine = (j == x) ? c : mine; }
        if (sum == G) break;
        __builtin_amdgcn_s_sleep(1);
        if ((++sp & 255u) == 0u) { if (xb_ld(&bar[XB_TMO])) break; if (sp > XB_SPIN_CAP) { atomicAdd(&bar[XB_TMO], 1u); break; } }
    }
    nloc = mine > 0u ? mine : 1u; nx = cnt > 0u ? cnt : 1u;
}

__device__ __forceinline__ void xcd_barrier(const XcdBarrier& b) {
    asm volatile("s_waitcnt vmcnt(0)" ::: "memory");
    __syncthreads();
    if (threadIdx.x == 0) {
        unsigned* bar = b.bar;
        __builtin_amdgcn_s_waitcnt(0);
        unsigned nloc = b.st[0], nx = b.st[1];
        if (nloc == 0u) { xcd_barrier_complete(bar, b.x, nloc, nx); b.st[0] = nloc; b.st[1] = nx; }
        const unsigned old = xb_add(&bar[XB_XSUB(b.x)], 1u);
        const unsigned gen = old / nloc;
        if (old + 1u == (gen + 1u) * nloc) {
            __builtin_amdgcn_fence(__ATOMIC_RELEASE, "agent");
            asm volatile("s_waitcnt vmcnt(0)" ::: "memory");
            const unsigned og = xb_add(&bar[XB_TOP], 1u);
            const unsigned tg = og / nx;
            if (og + 1u == (tg + 1u) * nx) xb_add(&bar[XB_TOPGEN], 1u);
            else XB_SPIN(xb_ld(&bar[XB_TOPGEN]) == tg, bar);
            __builtin_amdgcn_fence(__ATOMIC_ACQUIRE, "agent");
            xb_add(&bar[XB_XGEN(b.x)], 1u);
            asm volatile("s_waitcnt vmcnt(0)" ::: "memory");
        } else {
            XB_SPIN(xb_ld(&bar[XB_XGEN(b.x)]) == gen, bar);
            __builtin_amdgcn_fence(__ATOMIC_ACQUIRE, "agent");
            asm volatile("s_waitcnt vmcnt(0)" ::: "memory");
        }
    }
    __syncthreads();
}

constexpr int NPHASE = 12;
__global__ void __launch_bounds__(512, 2) mega_fwd(Args a) {
    extern __shared__ __attribute__((aligned(16))) unsigned char lds[];
    LAS unsigned char* L = (LAS unsigned char*)lds;
    const int lo = a.ph_lo, hi = a.ph_hi;
    const int G = gridDim.x, c = blockIdx.x;
#ifndef PH_MASK
#define PH_MASK 0xFFFF
#endif
#define IN(k) (((PH_MASK >> (k)) & 1) && lo <= (k) && (k) < hi)
#define SEAM(k) do { if (IN(k) && IN((k) + 1)) { if ((k) == 0) cg::this_grid().sync(); else xcd_barrier(xbar); } } while (0)
    volatile LAS unsigned* xst = (volatile LAS unsigned*)(L + LDS_XBAR);
    if (threadIdx.x < 2) xst[threadIdx.x] = 0u;
    __syncthreads();
    XcdBarrier xbar = xcd_barrier_post((unsigned*)(a.ws + WS_BAR), xst);
    float* mods = (float*)(a.ws + WS_MODS);
    bf16* H = (bf16*)(a.ws + WS_H); bf16* P = (bf16*)(a.ws + WS_P);
    float* CTX1 = (float*)(a.ws + WS_CTX1);
    if (IN(0)) { ph_prologue(a, L); } SEAM(0);
    if (IN(1)) { ph_norm(a, 0, a.in[I_X], a.in[I_CTX]); } SEAM(1);
    if (IN(2)) { pg8::Gemm g{H, (const bf16*)(a.ws + WS_WT0), MT, N0P, 2048}; pg8::StaticOrder S; S.init(MT, N0P, G, c);
        pg8::EpiIn E{P, N0, N0, (float*)(a.ws + WS_R), 1024, 0.0625f};
        pg8::gemm_phase<pg8::EpiIn, pg8::StaticOrder, true, true>(L, g, S, E); } SEAM(2);
    if (IN(3)) { ph_gla_pre(a, L); } SEAM(3);
    if (IN(4)) { ph_gla_scan(a, L); } SEAM(4);
    if (IN(5)) { ph_gla_finish(a); } SEAM(5);
    if (IN(6)) { pg8::Gemm g{H, (const bf16*)(a.ws + WS_WT1), MT, 2048, 2048}; pg8::StaticOrder S; S.init(MT, 2048, G, c);
        pg8::EpiOut E{a.in[I_X], a.out, a.in[I_CTX], CTX1, mods};
        pg8::gemm_phase<pg8::EpiOut, pg8::StaticOrder, true, true>(L, g, S, E); } SEAM(6);
    if (IN(7)) { ph_norm(a, 1, a.out, CTX1); } SEAM(7);
    if (IN(8)) { pg8::Gemm g{H, (const bf16*)(a.ws + WS_WT2), MT, N1, 2048}; pg8::StaticOrder S; S.init(MT, N1, G, c);
        pg8::EpiInD E{P, P + (size_t)130 * MiB / 2, P + (size_t)260 * MiB / 2, P + (size_t)390 * MiB / 2};
        pg8::gemm_phase<pg8::EpiInD, pg8::StaticOrder, true, true>(L, g, S, E); } SEAM(8);
    if (IN(9)) { ph_qk_post(a); } SEAM(9);
    if (IN(10)) { ph_attn(a, lds); } SEAM(10);
    if (IN(11)) { pg8::Gemm g{H, (const bf16*)(a.ws + WS_WT3), MT, 2048, 2048}; pg8::LatentOrder S; S.init(G, c);
        pg8::EpiOut E{a.out, a.out, nullptr, nullptr, mods + 3 * 6144};
        pg8::gemm_phase<pg8::EpiOut, pg8::LatentOrder, true, true>(L, g, S, E); }
#undef IN
#undef SEAM
}

extern "C" void kernel_launch(void* const* d_in, const int* in_sizes, int n_in, void* d_out, int out_size, void* d_ws, size_t ws_size, hipStream_t stream) {
    static int grid = 0;
    if (grid == 0) {
        if (n_in != 19 || out_size != NB * SEQ * DM || ws_size < WS_END) { fprintf(stderr, "kernel_launch: unexpected shapes: n_in %d out %d ws %zu (need %zu)\n", n_in, out_size, ws_size, (size_t)WS_END); grid = -1; return; }
        int dev = 0, cus = 0, per_cu = 0;
        hipGetDevice(&dev); hipDeviceGetAttribute(&cus, hipDeviceAttributeMultiprocessorCount, dev);
        if (hipFuncSetAttribute((const void*)mega_fwd, hipFuncAttributeMaxDynamicSharedMemorySize, LDS_BYTES) != hipSuccess) { fprintf(stderr, "kernel_launch: hipFuncSetAttribute failed\n"); grid = -1; return; }
        if (hipOccupancyMaxActiveBlocksPerMultiprocessor(&per_cu, (const void*)mega_fwd, 512, LDS_BYTES) != hipSuccess || per_cu < 1) { fprintf(stderr, "kernel_launch: occupancy query says %d\n", per_cu); per_cu = 1; }
        (void)hipGetLastError();
        grid = cus * per_cu;
        fprintf(stderr, "kernel_launch: grid %d (cus %d x %d), ws %zu\n", grid, cus, per_cu, ws_size);
    }
    if (grid < 0) return;
    hipMemsetAsync((char*)d_ws + WS_MODS, 0, CTL_ZERO_BYTES, stream);
    Args a{};
    for (int i = 0; i < 19; ++i) a.in[i] = (const float*)d_in[i];
    a.out = (float*)d_out; a.ws = (unsigned char*)d_ws;
#ifdef PROBE_RANGES
    { const int rg[] = PROBE_RANGES; for (unsigned k = 0; k + 1 < sizeof(rg) / sizeof(int); k += 2) { a.ph_lo = rg[k]; a.ph_hi = rg[k + 1]; void* args[] = {&a};
        hipError_t e = hipLaunchCooperativeKernel((const void*)mega_fwd, dim3(grid), dim3(512), args, LDS_BYTES, stream);
        if (e != hipSuccess) fprintf(stderr, "kernel_launch: cooperative launch failed: %s (grid %d)\n", hipGetErrorString(e), grid); } }
#else
    a.ph_lo = 0; a.ph_hi = NPHASE;
    void* args[] = {&a};
    hipError_t e = hipLaunchCooperativeKernel((const void*)mega_fwd, dim3(grid), dim3(512), args, LDS_BYTES, stream);
    if (e != hipSuccess) fprintf(stderr, "kernel_launch: cooperative launch failed: %s (grid %d)\n", hipGetErrorString(e), grid);
#endif
}
```

```cpp
#include <hip/hip_runtime.h>
#include <hip/hip_bf16.h>
#include <hip/hip_cooperative_groups.h>
#include <cstdio>
#include <cstdint>
namespace cg = cooperative_groups;
#ifndef MK_LAUNCHES
#define MK_LAUNCHES 1
#endif
namespace pg8 {
#define PG8_LAS __attribute__((address_space(3)))
typedef unsigned short bf16_t;
typedef short bf16x8 __attribute__((ext_vector_type(8)));
typedef float f32x4 __attribute__((ext_vector_type(4)));
typedef unsigned u32x4 __attribute__((ext_vector_type(4)));
constexpr int BM = 256, BK = 64, HALF = 128, HTB = HALF * BK * 2  , STAGE_BYTES = 8 * HTB, NXCD = 8, WGM = 8;

__host__ __device__ __forceinline__ int lds_byte(int r, int c) { const int st = (r >> 4) * 2 + (c >> 5), rr = r & 15, cc = c & 31, ob = rr * 64 + cc * 2; return st * 1024 + (ob ^ (((ob >> 9) & 1) << 5)); }
__host__ __device__ __forceinline__ void stage_rc(int b, int& R, int& C) { const int st = b / 1024, sb = b % 1024, swz = sb ^ (((sb >> 9) & 1) << 5); R = (st >> 1) * 16 + swz / 64; C = (st & 1) * 32 + (swz % 64) / 2; }
__host__ __device__ __forceinline__ int perm32(int rho) { const int n = rho >> 4, i = rho & 15; return 8 * (i >> 2) + 4 * n + (i & 3); }

struct Unit { int pm, pn; };
struct Gemm { const bf16_t* A; const bf16_t* Bt; int M, N, K; };

struct StaticOrder {
    int nM, nN, nwg, G, c;
    __host__ __device__ void init(int M, int N, int G_, int c_) { nM = M / BM; nN = N / BM; nwg = nM * nN; G = G_; c = c_; }
    __host__ __device__ bool next(int i, Unit& u) const {
        const long L = (long)i * G + c; if (L >= nwg) return false;
        int wgid = (int)L; { const int q = nwg / NXCD, r = nwg % NXCD, xcd = wgid % NXCD, off = wgid / NXCD; wgid = (xcd < r ? xcd * (q + 1) : r * (q + 1) + (xcd - r) * q) + off; }
        const int nig = WGM * nN, gid = wgid / nig, fm = gid * WGM, gsz = (nM - fm) < WGM ? (nM - fm) : WGM;
        u.pm = fm + ((wgid % nig) % gsz); u.pn = (wgid % nig) / gsz; return true;
    }
    __device__ __forceinline__ void a_ready(const Unit&) const {}
    __device__ __forceinline__ void done(const Unit&) const {}
};
__device__ __forceinline__ unsigned cvt_pk_bf16(float lo, float hi) { unsigned r; asm volatile("v_cvt_pk_bf16_f32 %0, %1, %2" : "=v"(r) : "v"(lo), "v"(hi)); return r; }
typedef float f32x2 __attribute__((ext_vector_type(2)));
typedef unsigned u32x2v __attribute__((ext_vector_type(2)));
typedef __bf16 bf16x2v_ __attribute__((ext_vector_type(2)));
typedef float f32x2v_ __attribute__((ext_vector_type(2)));
__device__ __forceinline__ unsigned cvt2v(float lo, float hi) { const f32x2v_ v = {lo, hi}; const bf16x2v_ b = __builtin_convertvector(v, bf16x2v_); return __builtin_bit_cast(unsigned, b); }
struct EpiIn {
    static constexpr bool PERM = true, AFTER_DRAIN = false;
    bf16_t* O; int ldc; int ncols_main; float* R; int qcols; float qscale;
    __device__ __forceinline__ void operator()(const f32x4 (&acc)[2][2][4][2], const Unit& u, int wr, int wc, int fr, int fq) const {
        const int row0 = u.pm * BM + wr * 64 + fr; const int colt = u.pn * BM;
        if (colt >= ncols_main) {
            if (wc == 0) {
#pragma unroll
                for (int ai = 0; ai < 2; ++ai)
#pragma unroll
                    for (int m = 0; m < 4; ++m) { float* rp = R + (size_t)(row0 + ai * HALF + m * 16) * 32 + 8 * fq;
                        *(f32x4*)(rp) = acc[ai][0][m][0]; *(f32x4*)(rp + 4) = acc[ai][0][m][1]; }
            }
            return;
        }
        const float sc = (colt < qcols) ? qscale : 1.f;
        const int col0 = colt + wc * 32 + 8 * fq;
#pragma unroll
        for (int ai = 0; ai < 2; ++ai)
#pragma unroll
            for (int m = 0; m < 4; ++m) { bf16_t* rowp = O + (size_t)(row0 + ai * HALF + m * 16) * ldc + col0;
#pragma unroll
                for (int bj = 0; bj < 2; ++bj) { const f32x4 v0 = acc[ai][bj][m][0] * sc, v1 = acc[ai][bj][m][1] * sc;
                    u32x4 w; w.x = cvt_pk_bf16(v0[0], v0[1]); w.y = cvt_pk_bf16(v0[2], v0[3]); w.z = cvt_pk_bf16(v1[0], v1[1]); w.w = cvt_pk_bf16(v1[2], v1[3]);
                    *(u32x4*)(rowp + bj * HALF) = w; } }
    }
};
struct EpiInD {
    static constexpr bool PERM = true, AFTER_DRAIN = false;
    bf16_t* QD; bf16_t* KD; bf16_t* VD; bf16_t* G;
    __device__ __forceinline__ void operator()(const f32x4 (&acc)[2][2][4][2], const Unit& u, int wr, int wc, int fr, int fq) const {
        const int b = u.pm / 65, t0 = (u.pm % 65) * 256 + wr * 64 + fr; const int reg = u.pn >> 3, h = u.pn & 7;
        const int cl = wc * 32 + 8 * fq;
#pragma unroll
        for (int ai = 0; ai < 2; ++ai)
#pragma unroll
            for (int m = 0; m < 4; ++m) { const int t = t0 + ai * HALF + m * 16;
#pragma unroll
                for (int bj = 0; bj < 2; ++bj) { const f32x4 v0 = acc[ai][bj][m][0], v1 = acc[ai][bj][m][1];
                    u32x4 w; w.x = cvt2v(v0[0], v0[1]); w.y = cvt2v(v0[2], v0[3]); w.z = cvt2v(v1[0], v1[1]); w.w = cvt2v(v1[2], v1[3]);
                    bf16_t* dst;
                    if (reg == 0)      dst = QD + ((((size_t)(b * 8 + h) * 2 + bj) * 16640 + t) * 128 + cl);
                    else if (reg == 1) dst = KD + ((((size_t)(b * 8 + h) * 2 + bj) * 16640 + t) * 128 + cl);
                    else if (reg == 2) dst = VD + (((size_t)(b * 8 + h) * 16640 + t) * 256 + bj * HALF + cl);
                    else               dst = G + ((size_t)(b * 16640 + t) * 2048 + h * 256 + bj * HALF + cl);
                    *(u32x4*)dst = w; } }
    }
};
struct EpiOut {
    static constexpr bool PERM = true, AFTER_DRAIN = false;
    const float* baseL; float* outL; const float* baseC; float* outC; const float* mods;
    __device__ __forceinline__ void operator()(const f32x4 (&acc)[2][2][4][2], const Unit& u, int wr, int wc, int fr, int fq) const {
        const int b = u.pm / 65, tt = u.pm % 65;
        const float* base; float* out; const float* g; size_t rbase;
        if (tt < 64) { base = baseL; out = outL; rbase = (size_t)(b * 64 + tt) * 256; g = mods + b * 6144 + 4096; }
        else { base = baseC; out = outC; rbase = (size_t)b * 256; g = mods + 2 * 6144 + 4096; }
        const int col0 = u.pn * BM + wc * 32 + 8 * fq;
#pragma unroll
        for (int bj = 0; bj < 2; ++bj) { const f32x4 g0 = *(const f32x4*)(g + col0 + bj * HALF), g1 = *(const f32x4*)(g + col0 + bj * HALF + 4);
#pragma unroll
            for (int ai = 0; ai < 2; ++ai)
#pragma unroll
                for (int m = 0; m < 4; ++m) { const size_t off = (rbase + ai * HALF + wr * 64 + m * 16 + fr) * 2048 + col0 + bj * HALF;
                    const f32x4 b0 = *(const f32x4*)(base + off), b1 = *(const f32x4*)(base + off + 4);
                    *(f32x4*)(out + off) = b0 + g0 * acc[ai][bj][m][0]; *(f32x4*)(out + off + 4) = b1 + g1 * acc[ai][bj][m][1]; } }
    }
};
struct LatentOrder {
    StaticOrder S;
    __device__ void init(int G_, int c_) { S.init(32768, 2048, G_, c_); }
    __device__ bool next(int i, Unit& u) const { if (!S.next(i, u)) return false; u.pm += (u.pm >= 64) ? 1 : 0; return true; }
    __device__ __forceinline__ void a_ready(const Unit&) const {}
    __device__ __forceinline__ void done(const Unit&) const {}
};
template <class Epi, class Sched, bool ALIGN_EPI = false, bool SP2 = false>
__device__ __forceinline__ void gemm_phase(PG8_LAS unsigned char* lds, const Gemm g, const Sched& S, const Epi& E) {
    const int tid = threadIdx.x, wid = __builtin_amdgcn_readfirstlane(tid >> 6), lane = tid & 63, wr = wid >> 2, wc = wid & 3, fr = lane & 15, fq = lane >> 4;
    const int K = g.K, nt = K / BK;
    unsigned voffA[2], voffB[2];
#pragma unroll
    for (int i = 0; i < 2; ++i) { int R, C; stage_rc(tid * 16 + i * 8192, R, C); const int Rb = Epi::PERM ? ((R & ~31) + perm32(R & 31)) : R;
        voffA[i] = (unsigned)(R * K + C) * 2u; voffB[i] = (unsigned)(Rb * K + C) * 2u; }
    const size_t kstep = (size_t)(BK * 2);
    const size_t hstep = (size_t)HALF * K * 2;
    const size_t tstep = 2 * hstep;
    const unsigned ldsw = (unsigned)wid * 1024u;
    const int aoff = lds_byte(wr * 64 + fr, fq * 8), boff = lds_byte(wc * 32 + fr, fq * 8);
#define PG8_SA(b, h) (((b) * 2 + (h)) * HTB)
#define PG8_SB(b, h) ((4 + (b) * 2 + (h)) * HTB)
#define PG8_STAGE(bufoff, gbase, voff) do { _Pragma("unroll") for (int _i = 0; _i < 2; ++_i) \
        __builtin_amdgcn_global_load_lds((const unsigned*)((const char*)(gbase) + (voff)[_i]), (PG8_LAS unsigned*)(lds + (bufoff) + ldsw + _i * 8192), 16, 0, 0); } while (0)
#define PG8_LDA(dst, b, h) do { _Pragma("unroll") for (int m = 0; m < 4; ++m) _Pragma("unroll") for (int k = 0; k < 2; ++k) dst[m][k] = *(const PG8_LAS bf16x8*)(lds + PG8_SA(b, h) + aoff + m * 2048 + k * 1024); } while (0)
#define PG8_LDB(dst, b, h) do { _Pragma("unroll") for (int n = 0; n < 2; ++n) _Pragma("unroll") for (int k = 0; k < 2; ++k) dst[n][k] = *(const PG8_LAS bf16x8*)(lds + PG8_SB(b, h) + boff + n * 2048 + k * 1024); } while (0)
#define PG8_MMA(ai, bj, At, Bt) do { __builtin_amdgcn_s_setprio(1); _Pragma("unroll") for (int m = 0; m < 4; ++m) _Pragma("unroll") for (int n = 0; n < 2; ++n) _Pragma("unroll") for (int k = 0; k < 2; ++k) \
        acc[ai][bj][m][n] = __builtin_amdgcn_mfma_f32_16x16x32_bf16(Bt[n][k], At[m][k], acc[ai][bj][m][n], 0, 0, 0); __builtin_amdgcn_s_setprio(0); } while (0)
#define PG8_WAIT_V(n) asm volatile("s_waitcnt vmcnt(" #n ")" ::: "memory")
#define PG8_WAIT_L(n) asm volatile("s_waitcnt lgkmcnt(" #n ")" ::: "memory")
#define PG8_BAR __builtin_amdgcn_s_barrier()
#define PG8_SCHED __builtin_amdgcn_sched_barrier(0)
    Unit cur, nxt; int ui = 0;
    if (!S.next(0, cur)) return;
    f32x4 acc[2][2][4][2];
#pragma unroll
    for (int a = 0; a < 2; ++a)
#pragma unroll
        for (int b = 0; b < 2; ++b)
#pragma unroll
            for (int m = 0; m < 4; ++m)
#pragma unroll
                for (int n = 0; n < 2; ++n) acc[a][b][m][n] = (f32x4){0.f, 0.f, 0.f, 0.f};
    bf16x8 At[4][2], B0[2][2], B1[2][2];
    const char* cA = (const char*)g.A + (size_t)cur.pm * tstep; const char* cB = (const char*)g.Bt + (size_t)cur.pn * tstep;
    S.a_ready(cur);
    if constexpr (SP2) {
        PG8_STAGE(PG8_SB(0, 0), cB, voffB); PG8_STAGE(PG8_SB(0, 1), cB + hstep, voffB); PG8_STAGE(PG8_SA(0, 0), cA, voffA); PG8_STAGE(PG8_SA(0, 1), cA + hstep, voffA);
        if (wr == 1) PG8_BAR;
        PG8_WAIT_V(2); PG8_BAR;
        PG8_STAGE(PG8_SB(1, 0), cB + kstep, voffB); PG8_STAGE(PG8_SA(1, 0), cA + kstep, voffA); PG8_STAGE(PG8_SB(1, 1), cB + hstep + kstep, voffB);
        PG8_WAIT_V(6); PG8_BAR;
    } else {
        PG8_STAGE(PG8_SB(0, 0), cB, voffB); PG8_STAGE(PG8_SA(0, 0), cA, voffA); PG8_STAGE(PG8_SB(0, 1), cB + hstep, voffB); PG8_STAGE(PG8_SA(0, 1), cA + hstep, voffA);
        if (wr == 1) PG8_BAR;
        PG8_WAIT_V(4); PG8_BAR;
        PG8_STAGE(PG8_SB(1, 0), cB + kstep, voffB); PG8_STAGE(PG8_SA(1, 0), cA + kstep, voffA); PG8_STAGE(PG8_SB(1, 1), cB + hstep + kstep, voffB);
        PG8_WAIT_V(6); PG8_BAR;
    }
    for (;;) {
        const bool has_next = S.next(ui + 1, nxt);
        const char* nA = has_next ? (const char*)g.A + (size_t)nxt.pm * tstep : cA; const char* nB = has_next ? (const char*)g.Bt + (size_t)nxt.pn * tstep : cB;
        for (int t = 0; t < nt; t += 2) {
            const bool last = (t == nt - 2);
            const char* a1 = cA + (size_t)(t + 1) * kstep;
            const char* a2 = last ? nA : cA + (size_t)(t + 2) * kstep; const char* b2 = last ? nB : cB + (size_t)(t + 2) * kstep;
            const char* a3 = a2 + kstep; const char* b3 = b2 + kstep;
            if (last && has_next) S.a_ready(nxt);
            if constexpr (SP2) {
            PG8_LDB(B0, 0, 0); PG8_LDB(B1, 0, 1); PG8_SCHED; PG8_LDA(At, 0, 0); PG8_STAGE(PG8_SA(1, 1), a1 + hstep, voffA);
            PG8_WAIT_V(8); PG8_WAIT_L(0); PG8_BAR; PG8_MMA(0, 0, At, B0); PG8_MMA(0, 1, At, B1); PG8_BAR; PG8_SCHED;
            PG8_LDA(At, 0, 1); PG8_STAGE(PG8_SB(0, 0), b2, voffB); PG8_STAGE(PG8_SB(0, 1), b2 + hstep, voffB); PG8_STAGE(PG8_SA(0, 0), a2, voffA);
            PG8_WAIT_V(8); PG8_WAIT_L(0); PG8_BAR; PG8_MMA(1, 0, At, B0); PG8_MMA(1, 1, At, B1); PG8_BAR; PG8_SCHED;
            PG8_LDB(B0, 1, 0); PG8_LDB(B1, 1, 1); PG8_SCHED; PG8_LDA(At, 1, 0); PG8_STAGE(PG8_SA(0, 1), a2 + hstep, voffA);
            PG8_WAIT_V(8); PG8_WAIT_L(0); PG8_BAR; PG8_MMA(0, 0, At, B0); PG8_MMA(0, 1, At, B1); PG8_BAR; PG8_SCHED;
            PG8_LDA(At, 1, 1); PG8_STAGE(PG8_SB(1, 0), b3, voffB); PG8_STAGE(PG8_SB(1, 1), b3 + hstep, voffB); PG8_STAGE(PG8_SA(1, 0), a3, voffA);
            PG8_WAIT_V(8); PG8_WAIT_L(0); PG8_BAR; PG8_MMA(1, 0, At, B0); PG8_MMA(1, 1, At, B1); PG8_BAR; PG8_SCHED;
            } else {
            PG8_LDB(B0, 0, 0); PG8_SCHED; PG8_LDA(At, 0, 0); PG8_STAGE(PG8_SA(1, 1), a1 + hstep, voffA);
            PG8_WAIT_L(8); PG8_BAR; PG8_WAIT_L(0); PG8_MMA(0, 0, At, B0); PG8_BAR; PG8_SCHED;
            PG8_LDB(B1, 0, 1); PG8_STAGE(PG8_SB(0, 0), b2, voffB);
            PG8_BAR; PG8_WAIT_L(0); PG8_MMA(0, 1, At, B1); PG8_BAR;
            PG8_LDA(At, 0, 1); PG8_STAGE(PG8_SA(0, 0), a2, voffA);
            PG8_BAR; PG8_WAIT_L(0); PG8_MMA(1, 0, At, B0); PG8_BAR; PG8_SCHED;
            PG8_STAGE(PG8_SB(0, 1), b2 + hstep, voffB);
            PG8_WAIT_V(6); PG8_BAR; PG8_MMA(1, 1, At, B1); PG8_BAR;
            PG8_LDB(B0, 1, 0); PG8_SCHED; PG8_LDA(At, 1, 0); PG8_STAGE(PG8_SA(0, 1), a2 + hstep, voffA);
            PG8_WAIT_L(8); PG8_BAR; PG8_WAIT_L(0); PG8_MMA(0, 0, At, B0); PG8_BAR; PG8_SCHED;
            PG8_LDB(B1, 1, 1); PG8_STAGE(PG8_SB(1, 0), b3, voffB);
            PG8_BAR; PG8_WAIT_L(0); PG8_MMA(0, 1, At, B1); PG8_BAR;
            PG8_LDA(At, 1, 1); PG8_STAGE(PG8_SA(1, 0), a3, voffA);
            PG8_BAR; PG8_WAIT_L(0); PG8_MMA(1, 0, At, B0); PG8_BAR; PG8_SCHED;
            PG8_STAGE(PG8_SB(1, 1), b3 + hstep, voffB);
            PG8_WAIT_V(6); PG8_BAR; PG8_MMA(1, 1, At, B1); PG8_BAR;
            }
        }
        if constexpr (ALIGN_EPI) { if (wr == 0) PG8_BAR; }
        if constexpr (!Epi::AFTER_DRAIN) { E(acc, cur, wr, wc, fr, fq); S.done(cur); }
        if (!has_next) break;
#pragma unroll
        for (int a = 0; a < 2; ++a)
#pragma unroll
            for (int b = 0; b < 2; ++b)
#pragma unroll
                for (int m = 0; m < 4; ++m)
#pragma unroll
                    for (int n = 0; n < 2; ++n) acc[a][b][m][n] = (f32x4){0.f, 0.f, 0.f, 0.f};
        cur = nxt; cA = nA; cB = nB; ++ui;
        if constexpr (ALIGN_EPI) { if (wr == 1) PG8_BAR; }
    }
    PG8_WAIT_V(0);
    if constexpr (!ALIGN_EPI) { if (wr == 0) PG8_BAR; }
    PG8_BAR;
    if constexpr (Epi::AFTER_DRAIN) { E.fused(acc, cur, wr, wc, fr, fq, lds, wid, lane); S.done(cur); }
#undef PG8_SA
#undef PG8_SB
#undef PG8_STAGE
#undef PG8_LDA
#undef PG8_LDB
#undef PG8_MMA
#undef PG8_WAIT_V
#undef PG8_WAIT_L
#undef PG8_BAR
#undef PG8_SCHED
}
}
namespace attn {
using bf16 = __hip_bfloat16;
constexpr int   D = 128, NW = 8, QBLK = 32, KVBLK = 64;
constexpr float SCALE = 0.088388347648318440f;
constexpr float THR = 8.f;
constexpr int SDEPTH = 2;
constexpr int LDQ = 8192, LDK = 8192, LDO = 2048;
constexpr size_t SHM_V = KVBLK * D * 2, SHM_K = KVBLK * D * 2, SHM_ATTN = 2 * SHM_V + 2 * SHM_K + NW * 64 * 4;
typedef float f32x4v __attribute__((ext_vector_type(4)));
using bf16x8 = __attribute__((ext_vector_type(8))) short;
using s16x4  = __attribute__((ext_vector_type(4))) short;
using f32x16 = __attribute__((ext_vector_type(16))) float;
using f32x8  = __attribute__((ext_vector_type(8))) float;
using u32x4  = __attribute__((ext_vector_type(4))) unsigned;
#define KSWZ(row, colB) ((row) * 256 + ((colB) ^ (((row) & 7) << 4)))
#define SBAR() __builtin_amdgcn_sched_barrier(0)
__device__ __forceinline__ int crow(int r, int hi) { return (r & 3) + 8 * (r >> 2) + 4 * hi; }
__device__ __forceinline__ unsigned cvtpk(float lo, float hi) {
  unsigned r; asm volatile("v_cvt_pk_bf16_f32 %0, %1, %2" : "=v"(r) : "v"(lo), "v"(hi)); return r;
}
template <typename TIn> struct Stage;
template <> struct Stage<bf16>  { using T = bf16x8;
  __device__ static __forceinline__ T ld8(const bf16* p) { return *reinterpret_cast<const bf16x8*>(p); }
  __device__ static __forceinline__ bf16x8 tobf(T x) { return x; } };
template <> struct Stage<float> { using T = f32x8;
  __device__ static __forceinline__ T ld8(const float* p) { return *reinterpret_cast<const f32x8*>(p); }
  __device__ static __forceinline__ bf16x8 tobf(T x) {
    u32x4 w = {cvtpk(x[0], x[1]), cvtpk(x[2], x[3]), cvtpk(x[4], x[5]), cvtpk(x[6], x[7])}; return *reinterpret_cast<bf16x8*>(&w); } };

__device__ __forceinline__ void partialSM(f32x16& p0, f32x16& p1, float& m_reg, float& mn, float& alpha) {
  constexpr float C = SCALE * 1.4426950408889634f;
  float pmax = p0[0]; for (int r = 1; r < 16; ++r) pmax = fmaxf(pmax, p0[r]); for (int r = 0; r < 16; ++r) pmax = fmaxf(pmax, p1[r]);
  { auto rr = __builtin_amdgcn_permlane32_swap(__float_as_uint(pmax), __float_as_uint(pmax), false, false);
    pmax = fmaxf(__uint_as_float(rr[0]), __uint_as_float(rr[1])); }
  if (__builtin_expect(__all(pmax - m_reg <= THR / SCALE), 1)) { mn = m_reg; alpha = 1.f; }
  else { mn = fmaxf(m_reg, pmax); alpha = __builtin_amdgcn_exp2f((m_reg - mn) * C); m_reg = mn; }
  float mnC = -mn * C;
  for (int r = 0; r < 16; ++r) p0[r] = fmaf(p0[r], C, mnC); for (int r = 0; r < 16; ++r) p1[r] = fmaf(p1[r], C, mnC);
  for (int r = 0; r < 16; ++r) p0[r] = __builtin_amdgcn_exp2f(p0[r]);
}
__device__ __forceinline__ void finishSM(f32x16& p0, f32x16& p1, float alpha, float& l_reg, bf16x8& pa0, bf16x8& pa1, bf16x8& pa2, bf16x8& pa3) {
  for (int r = 0; r < 16; ++r) p1[r] = __builtin_amdgcn_exp2f(p1[r]);
  float ps = 0; for (int r = 0; r < 16; ++r) ps += p0[r]; for (int r = 0; r < 16; ++r) ps += p1[r];
  { auto rr = __builtin_amdgcn_permlane32_swap(__float_as_uint(ps), __float_as_uint(ps), false, false);
    ps = __uint_as_float(rr[0]) + __uint_as_float(rr[1]); }
  l_reg = l_reg * alpha + ps;
#define PK4(P, BASE, OUT) do { unsigned a0 = cvtpk(P[BASE + 0], P[BASE + 1]), a1 = cvtpk(P[BASE + 2], P[BASE + 3]);   \
    unsigned b0 = cvtpk(P[BASE + 4], P[BASE + 5]), b1 = cvtpk(P[BASE + 6], P[BASE + 7]);                              \
    auto r0 = __builtin_amdgcn_permlane32_swap(a0, b0, false, false); auto r1 = __builtin_amdgcn_permlane32_swap(a1, b1, false, false); \
    u32x4 w = {r0[0], r1[0], r0[1], r1[1]}; OUT = *reinterpret_cast<bf16x8*>(&w); } while (0)
  PK4(p0, 0, pa0); PK4(p0, 8, pa1); PK4(p1, 0, pa2); PK4(p1, 8, pa3);
#undef PK4
}
__device__ __forceinline__ void qkt(f32x16& p0, f32x16& p1, const bf16* Ks, const bf16x8* qr, int r32, int hi) {
  p0 = f32x16{}; p1 = f32x16{};
  for (int d0 = 0; d0 < 8; ++d0) { int cb = (d0 * 16 + hi * 8) * 2;
    bf16x8 b0 = *reinterpret_cast<const bf16x8*>((const char*)Ks + KSWZ(r32, cb));
    bf16x8 b1 = *reinterpret_cast<const bf16x8*>((const char*)Ks + KSWZ(32 + r32, cb));
    p0 = __builtin_amdgcn_mfma_f32_32x32x16_bf16(b0, qr[d0], p0, 0, 0, 0);
    p1 = __builtin_amdgcn_mfma_f32_32x32x16_bf16(b1, qr[d0], p1, 0, 0, 0); }
}
__device__ __forceinline__ int v_st(int k, int c) { const int kk = (k & ~0xC) | ((k & 4) << 1) | ((k & 8) >> 1); return ((kk >> 3) * 4 + (c >> 5)) * 512 + ((kk & 7) * 32 + (c & 31)) * 2; }
__device__ __forceinline__ int v_rd_base(int lane) { return ((lane & 3) << 3) | (((lane >> 2) & 3) << 6) | (((lane >> 4) & 1) << 5) | (((lane >> 5) & 1) << 8); }
constexpr int v_rd_off(int d0, int ks, int half) { return d0 * 512 + ks * 4096 + half * 2048; }
template <int OFF> __device__ __forceinline__ s16x4 tr_read(int vb) {
  s16x4 r; asm volatile("ds_read_b64_tr_b16 %0, %1 offset:%2" : "=&v"(r) : "v"(vb), "i"(OFF) : "memory"); return r;
}
template <int D0> __device__ __forceinline__ void pv_one(f32x16& od, int vb, bf16x8 pa0, bf16x8 pa1, bf16x8 pa2, bf16x8 pa3) {
  const s16x4 l0 = tr_read<v_rd_off(D0, 0, 0)>(vb), h0 = tr_read<v_rd_off(D0, 0, 1)>(vb), l1 = tr_read<v_rd_off(D0, 1, 0)>(vb), h1 = tr_read<v_rd_off(D0, 1, 1)>(vb);
  const s16x4 l2 = tr_read<v_rd_off(D0, 2, 0)>(vb), h2 = tr_read<v_rd_off(D0, 2, 1)>(vb), l3 = tr_read<v_rd_off(D0, 3, 0)>(vb), h3 = tr_read<v_rd_off(D0, 3, 1)>(vb);
  asm volatile("s_waitcnt lgkmcnt(0)" ::: "memory"); SBAR();
#define PK(L, H) (bf16x8){L[0], L[1], L[2], L[3], H[0], H[1], H[2], H[3]}
  od = __builtin_amdgcn_mfma_f32_32x32x16_bf16(pa0, PK(l0, h0), od, 0, 0, 0);
  od = __builtin_amdgcn_mfma_f32_32x32x16_bf16(pa1, PK(l1, h1), od, 0, 0, 0);
  od = __builtin_amdgcn_mfma_f32_32x32x16_bf16(pa2, PK(l2, h2), od, 0, 0, 0);
  od = __builtin_amdgcn_mfma_f32_32x32x16_bf16(pa3, PK(l3, h3), od, 0, 0, 0);
#undef PK
}
__device__ __forceinline__ void pv_d0(f32x16* o, int vb, bf16x8 pa0, bf16x8 pa1, bf16x8 pa2, bf16x8 pa3) {
  pv_one<0>(o[0], vb, pa0, pa1, pa2, pa3); pv_one<1>(o[1], vb, pa0, pa1, pa2, pa3); pv_one<2>(o[2], vb, pa0, pa1, pa2, pa3); pv_one<3>(o[3], vb, pa0, pa1, pa2, pa3);
}
template <int MODE>
__device__ __forceinline__ void attn_dense_body(const bf16* __restrict__ Qb, const bf16* __restrict__ Kh, const bf16* __restrict__ Vh,
                                                float* Ob, int seq, char* lds, float lam) {
  using St = Stage<bf16>; using SQ = Stage<bf16>;
  int tid_ = threadIdx.x; asm volatile("" : "+v"(tid_));
  const int tid = tid_, wid = tid >> 6, lane = tid & 63, r32 = lane & 31, hi = lane >> 5;
  bf16* V_lds = (bf16*)lds; bf16* K_lds = (bf16*)(lds + 2 * SHM_V);
  float* ws = (float*)(lds + 2 * SHM_V + 2 * SHM_K) + wid * 64; float* li_l = ws; float* al_l = ws + 32;
  float m_reg = -1e30f, l_reg = 0; f32x16 o[4] = {}; bf16x8 qr[8];
  const bf16* Qw = Qb + (long)(wid * QBLK + r32) * LDQ + hi * 8;
#pragma unroll
  for (int d0 = 0; d0 < 8; ++d0) qr[d0] = SQ::tobf(SQ::ld8(Qw + d0 * 16));
  const int sr = tid >> 4, sc = (tid & 15) * 8, vst0 = v_st(sr, sc), vst1 = v_st(32 + sr, sc);
  const int vb0 = (int)(uintptr_t)V_lds + v_rd_base(lane);
  struct { typename St::T vs0, vs1, ks0, ks1; } sr_[SDEPTH];
#define SLOAD(i, k0) do { sr_[i].vs0 = St::ld8(&Vh[(long)((k0) + sr) * LDK + sc]); sr_[i].vs1 = St::ld8(&Vh[(long)((k0) + 32 + sr) * LDK + sc]); \
    sr_[i].ks0 = St::ld8(&Kh[(long)((k0) + sr) * LDK + sc]); sr_[i].ks1 = St::ld8(&Kh[(long)((k0) + 32 + sr) * LDK + sc]); } while (0)
#define SWRITE(b, i) do { *(bf16x8*)((char*)V_lds + (b) * SHM_V + vst0) = St::tobf(sr_[i].vs0);          \
    *(bf16x8*)((char*)V_lds + (b) * SHM_V + vst1) = St::tobf(sr_[i].vs1); int kc = sc * 2;               \
    *(bf16x8*)((char*)K_lds + (b) * SHM_K + KSWZ(sr, kc)) = St::tobf(sr_[i].ks0);                       \
    *(bf16x8*)((char*)K_lds + (b) * SHM_K + KSWZ(32 + sr, kc)) = St::tobf(sr_[i].ks1); } while (0)
#define SWAIT() do { if constexpr (SDEPTH == 2) asm volatile("s_waitcnt vmcnt(4)" ::: "memory"); else asm volatile("s_waitcnt vmcnt(0)" ::: "memory"); } while (0)
#define RESC(a) do { if (__any((a) < 1.f)) { if (hi == 0) al_l[r32] = (a); asm volatile("s_waitcnt lgkmcnt(0)" ::: "memory"); \
    for (int d = 0; d < 4; ++d) for (int r = 0; r < 16; ++r) o[d][r] *= al_l[crow(r, hi)]; } } while (0)
  f32x16 pA0, pA1, pB0, pB1; float mnA, mnB, alA, alB; bf16x8 pa0, pa1, pa2, pa3; const int NT = seq / KVBLK;
  constexpr int SE = 0, SO = SDEPTH - 1;
  SLOAD(SE, 0); asm volatile("s_waitcnt vmcnt(0)" ::: "memory"); SWRITE(0, SE); __syncthreads();
  qkt(pA0, pA1, K_lds, qr, r32, hi); partialSM(pA0, pA1, m_reg, mnA, alA);
  SLOAD(SO, KVBLK); if constexpr (SDEPTH == 2) { if (2 < NT) SLOAD(SE, 2 * KVBLK); }
  SWAIT(); SWRITE(1, SO); __syncthreads();
  for (int j = 1; j + 1 < NT; j += 2) {
    SBAR(); qkt(pB0, pB1, (bf16*)((char*)K_lds + SHM_K), qr, r32, hi);
    finishSM(pA0, pA1, alA, l_reg, pa0, pa1, pa2, pa3); SBAR();
    SLOAD(SO, (j + SDEPTH) * KVBLK); SBAR();
    pv_d0(o, vb0, pa0, pa1, pa2, pa3); partialSM(pB0, pB1, m_reg, mnB, alB);
    __syncthreads(); SWAIT(); SWRITE(0, SE);
    RESC(alB); __syncthreads();
    SBAR(); qkt(pA0, pA1, K_lds, qr, r32, hi);
    finishSM(pB0, pB1, alB, l_reg, pa0, pa1, pa2, pa3); SBAR();
    if (SDEPTH == 1 || j + 3 < NT) SLOAD(SE, (j + 1 + SDEPTH) * KVBLK); SBAR();
    pv_d0(o, vb0 + (int)SHM_V, pa0, pa1, pa2, pa3); partialSM(pA0, pA1, m_reg, mnA, alA);
    __syncthreads(); SWAIT(); SWRITE(1, SO);
    RESC(alA); __syncthreads();
  }
  SBAR(); qkt(pB0, pB1, (bf16*)((char*)K_lds + SHM_K), qr, r32, hi);
  finishSM(pA0, pA1, alA, l_reg, pa0, pa1, pa2, pa3); SBAR();
  pv_d0(o, vb0, pa0, pa1, pa2, pa3); partialSM(pB0, pB1, m_reg, mnB, alB);
  __syncthreads(); RESC(alB);
  finishSM(pB0, pB1, alB, l_reg, pa0, pa1, pa2, pa3); SBAR();
  pv_d0(o, vb0 + (int)SHM_V, pa0, pa1, pa2, pa3);
  if (hi == 0) li_l[r32] = l_reg; asm volatile("s_waitcnt lgkmcnt(0)" ::: "memory");
  float rli[16];
#pragma unroll
  for (int r = 0; r < 16; ++r) rli[r] = __builtin_amdgcn_rcpf(li_l[crow(r, hi)]);
  float* Ow = Ob + (long)(wid * QBLK) * LDO;
#pragma unroll
  for (int r = 0; r < 16; ++r) { int orow = crow(r, hi);
    for (int d0 = 0; d0 < 4; ++d0) { float* op = &Ow[(long)orow * LDO + d0 * 32 + r32];
      if (MODE == 0) *op = o[d0][r] * rli[r]; else *op = *op - lam * (o[d0][r] * rli[r]); } }
  asm volatile("s_waitcnt vmcnt(0)" ::: "memory"); __syncthreads();
#undef SLOAD
#undef SWRITE
#undef SWAIT
#undef RESC
}
__device__ __forceinline__ bf16x8 pk8(const f32x16& P, int base) {
  unsigned a0 = cvtpk(P[base + 0], P[base + 1]), a1 = cvtpk(P[base + 2], P[base + 3]);
  unsigned b0 = cvtpk(P[base + 4], P[base + 5]), b1 = cvtpk(P[base + 6], P[base + 7]);
  auto r0 = __builtin_amdgcn_permlane32_swap(a0, b0, false, false); auto r1 = __builtin_amdgcn_permlane32_swap(a1, b1, false, false);
  u32x4 w = {r0[0], r1[0], r0[1], r1[1]}; return *reinterpret_cast<bf16x8*>(&w);
}
template <int DA, int DB> __device__ __forceinline__ void pv_pair(f32x16& oa, f32x16& ob, int vbase, bf16x8 f0, bf16x8 f1) {
  const s16x4 al0 = tr_read<v_rd_off(DA, 0, 0)>(vbase), ah0 = tr_read<v_rd_off(DA, 0, 1)>(vbase), al1 = tr_read<v_rd_off(DA, 1, 0)>(vbase), ah1 = tr_read<v_rd_off(DA, 1, 1)>(vbase);
  const s16x4 bl0 = tr_read<v_rd_off(DB, 0, 0)>(vbase), bh0 = tr_read<v_rd_off(DB, 0, 1)>(vbase), bl1 = tr_read<v_rd_off(DB, 1, 0)>(vbase), bh1 = tr_read<v_rd_off(DB, 1, 1)>(vbase);
  asm volatile("s_waitcnt lgkmcnt(0)" ::: "memory"); SBAR();
#define PK(L, H) (bf16x8){L[0], L[1], L[2], L[3], H[0], H[1], H[2], H[3]}
  __builtin_amdgcn_s_setprio(1);
  oa = __builtin_amdgcn_mfma_f32_32x32x16_bf16(f0, PK(al0, ah0), oa, 0, 0, 0);
  ob = __builtin_amdgcn_mfma_f32_32x32x16_bf16(f0, PK(bl0, bh0), ob, 0, 0, 0);
  oa = __builtin_amdgcn_mfma_f32_32x32x16_bf16(f1, PK(al1, ah1), oa, 0, 0, 0);
  ob = __builtin_amdgcn_mfma_f32_32x32x16_bf16(f1, PK(bl1, bh1), ob, 0, 0, 0);
  __builtin_amdgcn_s_setprio(0);
#undef PK
}
template <int DA, int DB> __device__ __forceinline__ void pv_pair_np(f32x16& oa, f32x16& ob, int vbase, bf16x8 f0, bf16x8 f1) {
  const s16x4 al0 = tr_read<v_rd_off(DA, 0, 0)>(vbase), ah0 = tr_read<v_rd_off(DA, 0, 1)>(vbase), al1 = tr_read<v_rd_off(DA, 1, 0)>(vbase), ah1 = tr_read<v_rd_off(DA, 1, 1)>(vbase);
  const s16x4 bl0 = tr_read<v_rd_off(DB, 0, 0)>(vbase), bh0 = tr_read<v_rd_off(DB, 0, 1)>(vbase), bl1 = tr_read<v_rd_off(DB, 1, 0)>(vbase), bh1 = tr_read<v_rd_off(DB, 1, 1)>(vbase);
  asm volatile("s_waitcnt lgkmcnt(0)" ::: "memory"); SBAR();
#define PK(L, H) (bf16x8){L[0], L[1], L[2], L[3], H[0], H[1], H[2], H[3]}
  oa = __builtin_amdgcn_mfma_f32_32x32x16_bf16(f0, PK(al0, ah0), oa, 0, 0, 0);
  ob = __builtin_amdgcn_mfma_f32_32x32x16_bf16(f0, PK(bl0, bh0), ob, 0, 0, 0);
  oa = __builtin_amdgcn_mfma_f32_32x32x16_bf16(f1, PK(al1, ah1), oa, 0, 0, 0);
  ob = __builtin_amdgcn_mfma_f32_32x32x16_bf16(f1, PK(bl1, bh1), ob, 0, 0, 0);
#undef PK
}
template <int DA, int DB> __device__ __forceinline__ void pv_pair_cw(f32x16& oa, f32x16& ob, int vbase, bf16x8 f0, bf16x8 f1) {
  const s16x4 al0 = tr_read<v_rd_off(DA, 0, 0)>(vbase), ah0 = tr_read<v_rd_off(DA, 0, 1)>(vbase), bl0 = tr_read<v_rd_off(DB, 0, 0)>(vbase), bh0 = tr_read<v_rd_off(DB, 0, 1)>(vbase);
  const s16x4 al1 = tr_read<v_rd_off(DA, 1, 0)>(vbase), ah1 = tr_read<v_rd_off(DA, 1, 1)>(vbase), bl1 = tr_read<v_rd_off(DB, 1, 0)>(vbase), bh1 = tr_read<v_rd_off(DB, 1, 1)>(vbase);
  asm volatile("s_waitcnt lgkmcnt(4)" ::: "memory"); SBAR();
#define PK(L, H) (bf16x8){L[0], L[1], L[2], L[3], H[0], H[1], H[2], H[3]}
  oa = __builtin_amdgcn_mfma_f32_32x32x16_bf16(f0, PK(al0, ah0), oa, 0, 0, 0);
  ob = __builtin_amdgcn_mfma_f32_32x32x16_bf16(f0, PK(bl0, bh0), ob, 0, 0, 0);
  SBAR(); asm volatile("s_waitcnt lgkmcnt(0)" ::: "memory"); SBAR();
  oa = __builtin_amdgcn_mfma_f32_32x32x16_bf16(f1, PK(al1, ah1), oa, 0, 0, 0);
  ob = __builtin_amdgcn_mfma_f32_32x32x16_bf16(f1, PK(bl1, bh1), ob, 0, 0, 0);
#undef PK
}
#define PVR(S, DA, DB, vbase) do { S[0] = tr_read<v_rd_off(DA, 0, 0)>(vbase); S[1] = tr_read<v_rd_off(DA, 0, 1)>(vbase); S[2] = tr_read<v_rd_off(DB, 0, 0)>(vbase); S[3] = tr_read<v_rd_off(DB, 0, 1)>(vbase); \
    S[4] = tr_read<v_rd_off(DA, 1, 0)>(vbase); S[5] = tr_read<v_rd_off(DA, 1, 1)>(vbase); S[6] = tr_read<v_rd_off(DB, 1, 0)>(vbase); S[7] = tr_read<v_rd_off(DB, 1, 1)>(vbase); } while (0)
#define PVK(L, H) (bf16x8){L[0], L[1], L[2], L[3], H[0], H[1], H[2], H[3]}
#define PVM(S, OA, OB, F0, F1) do { OA = __builtin_amdgcn_mfma_f32_32x32x16_bf16(F0, PVK(S[0], S[1]), OA, 0, 0, 0); OB = __builtin_amdgcn_mfma_f32_32x32x16_bf16(F0, PVK(S[2], S[3]), OB, 0, 0, 0); \
    OA = __builtin_amdgcn_mfma_f32_32x32x16_bf16(F1, PVK(S[4], S[5]), OA, 0, 0, 0); OB = __builtin_amdgcn_mfma_f32_32x32x16_bf16(F1, PVK(S[6], S[7]), OB, 0, 0, 0); } while (0)
#define PV_CHAIN4(O, v0, v1, F0, F1) do { s16x4 R0_[8], R1_[8]; \
    PVR(R0_, 0, 1, v0); PVR(R1_, 2, 3, v0); asm volatile("s_waitcnt lgkmcnt(8)" ::: "memory"); SBAR(); PVM(R0_, O[0], O[1], F0, F1); SBAR(); \
    PVR(R0_, 0, 1, v1); asm volatile("s_waitcnt lgkmcnt(8)" ::: "memory"); SBAR(); PVM(R1_, O[2], O[3], F0, F1); SBAR(); \
    PVR(R1_, 2, 3, v1); asm volatile("s_waitcnt lgkmcnt(8)" ::: "memory"); SBAR(); PVM(R0_, O[4], O[5], F0, F1); SBAR(); \
    asm volatile("s_waitcnt lgkmcnt(0)" ::: "memory"); SBAR(); PVM(R1_, O[6], O[7], F0, F1); } while (0)
#define PV_TAIL4(O, v0, v1, F0, F1) do { \
    PVR(R1_, 2, 3, v0); asm volatile("s_waitcnt lgkmcnt(8)" ::: "memory"); SBAR(); PVM(R0_, O[0], O[1], F0, F1); SBAR(); \
    PVR(R0_, 0, 1, v1); asm volatile("s_waitcnt lgkmcnt(8)" ::: "memory"); SBAR(); PVM(R1_, O[2], O[3], F0, F1); SBAR(); \
    PVR(R1_, 2, 3, v1); asm volatile("s_waitcnt lgkmcnt(8)" ::: "memory"); SBAR(); PVM(R0_, O[4], O[5], F0, F1); SBAR(); \
    asm volatile("s_waitcnt lgkmcnt(0)" ::: "memory"); SBAR(); PVM(R1_, O[6], O[7], F0, F1); } while (0)
constexpr int PAIR_LDS = 116736;
template <int MODE>
__device__ __forceinline__ void attn_pair_body(const bf16* __restrict__ Qb, const bf16* __restrict__ Kh, const bf16* __restrict__ Vh, float* Ob, int seq, char* lds, float lam, float negMc) {
  using St = Stage<bf16>;
  int tid_ = threadIdx.x; asm volatile("" : "+v"(tid_));
  const int tid = tid_, wid = tid >> 6, lane = tid & 63, r32 = lane & 31, hi = lane >> 5, g = wid >> 1, kh = wid & 1;
  char* K_lds = lds; char* V_lds = lds + 32768; char* X_lds = lds + 98304; float* L_lds = (float*)(lds + 114688);
  constexpr float C = SCALE * 1.4426950408889634f;
  f32x16 o[4] = {}; bf16x8 qr[8]; float lsum = 0.f;
  const bf16* Qw = Qb + (long)(g * 32 + r32) * LDQ + hi * 8;
#pragma unroll
  for (int d0 = 0; d0 < 8; ++d0) qr[d0] = St::ld8(Qw + d0 * 16);
  const int sr = tid >> 4, sc = (tid & 15) * 8, vst0 = v_st(sr, sc), vst1 = v_st(32 + sr, sc);
  const int vb = (int)(uintptr_t)V_lds + kh * 16384 + v_rd_base(lane);
  const int vbA = vb + 2 * kh * 4096, vbB = vb + 2 * (1 - kh) * 4096;
  const int krow = 32 * kh + r32;
  char* xw = X_lds + (wid * 64 + lane) * 32; const char* xr = X_lds + ((wid ^ 1) * 64 + lane) * 32;
  bf16x8 sk0, sk1, sv0, sv1, sv2, sv3;
#define PLOAD(k0) do { sk0 = St::ld8(&Kh[(long)((k0) + sr) * LDK + sc]); sk1 = St::ld8(&Kh[(long)((k0) + 32 + sr) * LDK + sc]); \
    sv0 = St::ld8(&Vh[(long)((k0) + sr) * LDK + sc]); sv1 = St::ld8(&Vh[(long)((k0) + 32 + sr) * LDK + sc]); \
    sv2 = St::ld8(&Vh[(long)((k0) + sr) * LDK + 128 + sc]); sv3 = St::ld8(&Vh[(long)((k0) + 32 + sr) * LDK + 128 + sc]); } while (0)
#define PWRITE(b) do { *(bf16x8*)(K_lds + (b) * 16384 + KSWZ(sr, sc * 2)) = sk0; *(bf16x8*)(K_lds + (b) * 16384 + KSWZ(32 + sr, sc * 2)) = sk1; \
    *(bf16x8*)(V_lds + (b) * 32768 + vst0) = sv0; *(bf16x8*)(V_lds + (b) * 32768 + vst1) = sv1; \
    *(bf16x8*)(V_lds + (b) * 32768 + 16384 + vst0) = sv2; *(bf16x8*)(V_lds + (b) * 32768 + 16384 + vst1) = sv3; } while (0)
  const int NT = seq / KVBLK;
  PLOAD(0); PWRITE(0); PLOAD(KVBLK); __syncthreads();
  for (int j = 0; j < NT; ++j) {
    const int buf = j & 1;
    const char* Kb = K_lds + buf * 16384;
    f32x16 pe = {}, po = {};
#pragma unroll
    for (int d0 = 0; d0 < 8; d0 += 2) {
      const bf16x8 k0 = *reinterpret_cast<const bf16x8*>(Kb + KSWZ(krow, (d0 * 16 + hi * 8) * 2));
      const bf16x8 k1 = *reinterpret_cast<const bf16x8*>(Kb + KSWZ(krow, ((d0 + 1) * 16 + hi * 8) * 2));
      pe = __builtin_amdgcn_mfma_f32_32x32x16_bf16(k0, qr[d0], pe, 0, 0, 0);
      po = __builtin_amdgcn_mfma_f32_32x32x16_bf16(k1, qr[d0 + 1], po, 0, 0, 0); }
    f32x16 p;
#pragma unroll
    for (int r = 0; r < 16; ++r) p[r] = __builtin_amdgcn_exp2f(fmaf(pe[r] + po[r], C, negMc));
    float ps = 0.f;
#pragma unroll
    for (int r = 0; r < 16; ++r) ps += p[r];
    lsum += ps;
    const bf16x8 own0 = pk8(p, 0), own1 = pk8(p, 8);
    *(bf16x8*)(xw) = own0; *(bf16x8*)(xw + 16) = own1;
    const int vo = buf * 32768;
    SBAR();
    pv_pair<0, 1>(o[0], o[1], vbA + vo, own0, own1); pv_pair<2, 3>(o[2], o[3], vbA + vo, own0, own1);
    __syncthreads();
    const bf16x8 pt0 = *(const bf16x8*)(xr), pt1 = *(const bf16x8*)(xr + 16);
    if (j + 1 < NT) { PWRITE(buf ^ 1); }
    if (j + 2 < NT) { PLOAD((j + 2) * KVBLK); }
    SBAR();
    pv_pair<0, 1>(o[0], o[1], vbB + vo, pt0, pt1); pv_pair<2, 3>(o[2], o[3], vbB + vo, pt0, pt1);
    __syncthreads();
  }
  L_lds[(wid * 2 + hi) * 32 + r32] = lsum;
  __syncthreads();
  float rli[16];
#pragma unroll
  for (int r = 0; r < 16; ++r) { const int row = crow(r, hi); const float* lp = L_lds + (g * 4) * 32 + row; rli[r] = __builtin_amdgcn_rcpf((lp[0] + lp[32]) + (lp[64] + lp[96])); }
  float* Ow = Ob + (long)(g * 32) * LDO + kh * 128;
#pragma unroll
  for (int r = 0; r < 16; ++r) { const int orow = crow(r, hi);
    for (int d0 = 0; d0 < 4; ++d0) { float* op = &Ow[(long)orow * LDO + d0 * 32 + r32];
      if (MODE == 0) *op = o[d0][r] * rli[r]; else *op = *op - lam * (o[d0][r] * rli[r]); } }
  asm volatile("s_waitcnt vmcnt(0)" ::: "memory"); __syncthreads();
#undef PLOAD
#undef PWRITE
}
template <int MODE>
__device__ __forceinline__ void attn_stag_body(const bf16* __restrict__ Qb, const bf16* __restrict__ Kh, const bf16* __restrict__ Vh, float* Ob, int seq, char* lds, float lam, float negMc) {
  using St = Stage<bf16>;
  int tid_ = threadIdx.x; asm volatile("" : "+v"(tid_));
  const int tid = tid_, wid = tid >> 6, lane = tid & 63, r32 = lane & 31, hi = lane >> 5, g = wid >> 1, kh = wid & 1;
  const bool early = wid < 4;
  char* K_lds = lds; char* V_lds = lds + 32768; char* X_lds = lds + 98304; float* L_lds = (float*)(lds + 114688);
  constexpr float C = SCALE * 1.4426950408889634f;
  f32x16 o[4] = {}; bf16x8 qr[8]; float lsum = 0.f;
  const bf16* Qw = Qb + (long)(g * 32 + r32) * LDQ + hi * 8;
#pragma unroll
  for (int d0 = 0; d0 < 8; ++d0) qr[d0] = St::ld8(Qw + d0 * 16);
  const int vb = (int)(uintptr_t)V_lds + kh * 16384 + v_rd_base(lane);
  const int vbA = vb + 2 * kh * 4096, vbB = vb + 2 * (1 - kh) * 4096;
  const int krow = 32 * kh + r32;
  char* xw = X_lds + (wid * 64 + lane) * 32; const char* xr = X_lds + ((wid ^ 1) * 64 + lane) * 32;
  const int NT = seq / KVBLK;
  { const int sr = tid >> 4, sc = (tid & 15) * 8;
    const bf16x8 a0 = St::ld8(&Kh[(long)(sr) * LDK + sc]), a1 = St::ld8(&Kh[(long)(32 + sr) * LDK + sc]);
    const bf16x8 b0 = St::ld8(&Vh[(long)(sr) * LDK + sc]), b1 = St::ld8(&Vh[(long)(32 + sr) * LDK + sc]), b2 = St::ld8(&Vh[(long)(sr) * LDK + 128 + sc]), b3 = St::ld8(&Vh[(long)(32 + sr) * LDK + 128 + sc]);
    const bf16x8 c0 = St::ld8(&Kh[(long)(64 + sr) * LDK + sc]), c1 = St::ld8(&Kh[(long)(96 + sr) * LDK + sc]);
    *(bf16x8*)(K_lds + KSWZ(sr, sc * 2)) = a0; *(bf16x8*)(K_lds + KSWZ(32 + sr, sc * 2)) = a1;
    *(bf16x8*)(V_lds + v_st(sr, sc)) = b0; *(bf16x8*)(V_lds + v_st(32 + sr, sc)) = b1; *(bf16x8*)(V_lds + 16384 + v_st(sr, sc)) = b2; *(bf16x8*)(V_lds + 16384 + v_st(32 + sr, sc)) = b3;
    *(bf16x8*)(K_lds + 16384 + KSWZ(sr, sc * 2)) = c0; *(bf16x8*)(K_lds + 16384 + KSWZ(32 + sr, sc * 2)) = c1; }
  const int th = tid & 255, sr = th >> 4, sc = (th & 15) * 8;
  bf16x8 st[8];
#define LOADV(k0) do { _Pragma("unroll") for (int q = 0; q < 4; ++q) { st[q] = St::ld8(&Vh[(long)((k0) + sr + 16 * q) * LDK + sc]); st[4 + q] = St::ld8(&Vh[(long)((k0) + sr + 16 * q) * LDK + 128 + sc]); } } while (0)
#define WRITEV(b) do { _Pragma("unroll") for (int q = 0; q < 4; ++q) { *(bf16x8*)(V_lds + (b) * 32768 + v_st(sr + 16 * q, sc)) = st[q]; *(bf16x8*)(V_lds + (b) * 32768 + 16384 + v_st(sr + 16 * q, sc)) = st[4 + q]; } } while (0)
#define LOADK(k0) do { _Pragma("unroll") for (int q = 0; q < 4; ++q) st[q] = St::ld8(&Kh[(long)((k0) + sr + 16 * q) * LDK + sc]); } while (0)
#define WRITEK(b) do { _Pragma("unroll") for (int q = 0; q < 4; ++q) *(bf16x8*)(K_lds + (b) * 16384 + KSWZ(sr + 16 * q, sc * 2)) = st[q]; } while (0)
  if (early) { LOADV(KVBLK); } else { LOADK(2 * KVBLK); }
  __syncthreads();
  if (!early) __syncthreads();
  for (int j = 0; j < NT; ++j) {
    const int buf = j & 1;
    const char* Kb = K_lds + buf * 16384;
    f32x16 pe = {}, po = {};
    __builtin_amdgcn_s_setprio(1);
#pragma unroll
    for (int d0 = 0; d0 < 8; d0 += 2) {
      const bf16x8 k0 = *reinterpret_cast<const bf16x8*>(Kb + KSWZ(krow, (d0 * 16 + hi * 8) * 2));
      const bf16x8 k1 = *reinterpret_cast<const bf16x8*>(Kb + KSWZ(krow, ((d0 + 1) * 16 + hi * 8) * 2));
      pe = __builtin_amdgcn_mfma_f32_32x32x16_bf16(k0, qr[d0], pe, 0, 0, 0);
      po = __builtin_amdgcn_mfma_f32_32x32x16_bf16(k1, qr[d0 + 1], po, 0, 0, 0); }
    __builtin_amdgcn_s_setprio(0);
    f32x16 p;
#pragma unroll
    for (int r = 0; r < 16; ++r) p[r] = __builtin_amdgcn_exp2f(fmaf(pe[r] + po[r], C, negMc));
    float ps = 0.f;
#pragma unroll
    for (int r = 0; r < 16; ++r) ps += p[r];
    lsum += ps;
    const bf16x8 own0 = pk8(p, 0), own1 = pk8(p, 8);
    *(bf16x8*)(xw) = own0; *(bf16x8*)(xw + 16) = own1;
    __syncthreads();
    const bf16x8 pt0 = *(const bf16x8*)(xr), pt1 = *(const bf16x8*)(xr + 16);
    if (early) { if (j + 1 < NT) { WRITEV(buf ^ 1); } if (j + 2 < NT) { LOADV((j + 2) * KVBLK); } }
    else       { if (j + 2 < NT) { WRITEK(buf); }     if (j + 3 < NT) { LOADK((j + 3) * KVBLK); } }
    const int vo = buf * 32768;
    SBAR();
    pv_pair<0, 1>(o[0], o[1], vbA + vo, own0, own1); pv_pair<2, 3>(o[2], o[3], vbA + vo, own0, own1);
    pv_pair<0, 1>(o[0], o[1], vbB + vo, pt0, pt1); pv_pair<2, 3>(o[2], o[3], vbB + vo, pt0, pt1);
    __syncthreads();
  }
  if (early) __syncthreads();
  L_lds[(wid * 2 + hi) * 32 + r32] = lsum;
  __syncthreads();
  float rli[16];
#pragma unroll
  for (int r = 0; r < 16; ++r) { const int row = crow(r, hi); const float* lp = L_lds + (g * 4) * 32 + row; rli[r] = __builtin_amdgcn_rcpf((lp[0] + lp[32]) + (lp[64] + lp[96])); }
  float* Ow = Ob + (long)(g * 32) * LDO + kh * 128;
#pragma unroll
  for (int r = 0; r < 16; ++r) { const int orow = crow(r, hi);
    for (int d0 = 0; d0 < 4; ++d0) { float* op = &Ow[(long)orow * LDO + d0 * 32 + r32];
      if (MODE == 0) *op = o[d0][r] * rli[r]; else *op = *op - lam * (o[d0][r] * rli[r]); } }
  asm volatile("s_waitcnt vmcnt(0)" ::: "memory"); __syncthreads();
#undef LOADV
#undef WRITEV
#undef LOADK
#undef WRITEK
}
template <int MODE>
__device__ __forceinline__ void attn_pair4_body(const bf16* __restrict__ Qb, const bf16* __restrict__ Kh, const bf16* __restrict__ Vh, float* Ob, int seq, char* lds, float lam, float negMc) {
  using St = Stage<bf16>;
  int tid_ = threadIdx.x; asm volatile("" : "+v"(tid_));
  const int tid = tid_, wid = tid >> 6, lane = tid & 63, r32 = lane & 31, hi = lane >> 5, g = wid >> 1, kh = wid & 1;
  char* K_lds = lds; char* V_lds = lds + 32768; char* X_lds = lds + 98304; float* L_lds = (float*)(lds + 114688);
  constexpr float C = SCALE * 1.4426950408889634f;
  f32x16 o[4] = {}; bf16x8 qr[8]; float lsum = 0.f;
  const bf16* Qw = Qb + (long)(g * 32 + r32) * 128 + hi * 8;
#pragma unroll
  for (int d0 = 0; d0 < 8; ++d0) qr[d0] = St::ld8(Qw + d0 * 16);
  const int sr = tid >> 4, sc = (tid & 15) * 8, vst0 = v_st(sr, sc), vst1 = v_st(32 + sr, sc);
  const int vb = (int)(uintptr_t)V_lds + kh * 16384 + v_rd_base(lane);
  const int vbA = vb + 2 * kh * 4096, vbB = vb + 2 * (1 - kh) * 4096;
  const int krow = 32 * kh + r32;
  char* xw = X_lds + (wid * 64 + lane) * 32; const char* xr = X_lds + ((wid ^ 1) * 64 + lane) * 32;
  bf16x8 sk0, sk1, sv0, sv1, sv2, sv3;
#define PLOAD(k0) do { sk0 = St::ld8(&Kh[(long)((k0) + sr) * 128 + sc]); sk1 = St::ld8(&Kh[(long)((k0) + 32 + sr) * 128 + sc]); \
    sv0 = St::ld8(&Vh[(long)((k0) + sr) * 256 + sc]); sv1 = St::ld8(&Vh[(long)((k0) + 32 + sr) * 256 + sc]); \
    sv2 = St::ld8(&Vh[(long)((k0) + sr) * 256 + 128 + sc]); sv3 = St::ld8(&Vh[(long)((k0) + 32 + sr) * 256 + 128 + sc]); } while (0)
#define PWRITE(b) do { *(bf16x8*)(K_lds + (b) * 16384 + KSWZ(sr, sc * 2)) = sk0; *(bf16x8*)(K_lds + (b) * 16384 + KSWZ(32 + sr, sc * 2)) = sk1; \
    *(bf16x8*)(V_lds + (b) * 32768 + vst0) = sv0; *(bf16x8*)(V_lds + (b) * 32768 + vst1) = sv1; \
    *(bf16x8*)(V_lds + (b) * 32768 + 16384 + vst0) = sv2; *(bf16x8*)(V_lds + (b) * 32768 + 16384 + vst1) = sv3; } while (0)
  const int NT = seq / KVBLK;
  PLOAD(0); PWRITE(0); PLOAD(KVBLK); __syncthreads();
  for (int j = 0; j < NT; ++j) {
    const int buf = j & 1;
    const char* Kb = K_lds + buf * 16384;
    f32x16 pe = {}, po = {};
#pragma unroll
    for (int d0 = 0; d0 < 8; d0 += 2) {
      const bf16x8 k0 = *reinterpret_cast<const bf16x8*>(Kb + KSWZ(krow, (d0 * 16 + hi * 8) * 2));
      const bf16x8 k1 = *reinterpret_cast<const bf16x8*>(Kb + KSWZ(krow, ((d0 + 1) * 16 + hi * 8) * 2));
      pe = __builtin_amdgcn_mfma_f32_32x32x16_bf16(k0, qr[d0], pe, 0, 0, 0);
      po = __builtin_amdgcn_mfma_f32_32x32x16_bf16(k1, qr[d0 + 1], po, 0, 0, 0); }
    f32x16 p;
#pragma unroll
    for (int r = 0; r < 16; ++r) p[r] = __builtin_amdgcn_exp2f(fmaf(pe[r] + po[r], C, negMc));
    float ps = 0.f;
#pragma unroll
    for (int r = 0; r < 16; ++r) ps += p[r];
    lsum += ps;
    const bf16x8 own0 = pk8(p, 0), own1 = pk8(p, 8);
    *(bf16x8*)(xw) = own0; *(bf16x8*)(xw + 16) = own1;
    const int vo = buf * 32768;
    SBAR();
    pv_pair<0, 1>(o[0], o[1], vbA + vo, own0, own1); pv_pair<2, 3>(o[2], o[3], vbA + vo, own0, own1);
    __syncthreads();
    const bf16x8 pt0 = *(const bf16x8*)(xr), pt1 = *(const bf16x8*)(xr + 16);
    if (j + 1 < NT) { PWRITE(buf ^ 1); }
    if (j + 2 < NT) { PLOAD((j + 2) * KVBLK); }
    SBAR();
    pv_pair<0, 1>(o[0], o[1], vbB + vo, pt0, pt1); pv_pair<2, 3>(o[2], o[3], vbB + vo, pt0, pt1);
    __syncthreads();
  }
  L_lds[(wid * 2 + hi) * 32 + r32] = lsum;
  __syncthreads();
  float rli[16];
#pragma unroll
  for (int r = 0; r < 16; ++r) { const int row = crow(r, hi); const float* lp = L_lds + (g * 4) * 32 + row; rli[r] = __builtin_amdgcn_rcpf((lp[0] + lp[32]) + (lp[64] + lp[96])); }
  float* Ow = Ob + (long)(g * 32) * LDO + kh * 128;
#pragma unroll
  for (int r = 0; r < 16; ++r) { const int orow = crow(r, hi);
    for (int d0 = 0; d0 < 4; ++d0) { float* op = &Ow[(long)orow * LDO + d0 * 32 + r32];
      if (MODE == 0) *op = o[d0][r] * rli[r]; else *op = *op - lam * (o[d0][r] * rli[r]); } }
  asm volatile("s_waitcnt vmcnt(0)" ::: "memory"); __syncthreads();
#undef PLOAD
#undef PWRITE
}
template <int MODE>
__device__ __forceinline__ void attn_pair5_body(const bf16* __restrict__ Qb, const bf16* __restrict__ Kh, const bf16* __restrict__ Vh, float* Ob, int seq, char* lds, float lam, float negMc) {
  using St = Stage<bf16>;
  int tid_ = threadIdx.x; asm volatile("" : "+v"(tid_));
  const int tid = tid_, wid = tid >> 6, lane = tid & 63, r32 = lane & 31, hi = lane >> 5, g = wid >> 1, kh = wid & 1;
  char* K_lds = lds; char* V_lds = lds + 32768; char* X_lds = lds + 98304; float* L_lds = (float*)(lds + 114688);
  constexpr float C = SCALE * 1.4426950408889634f;
  f32x16 o[4] = {}; bf16x8 qr[8]; float lsum = 0.f;
  const bf16* Qw = Qb + (long)(g * 32 + r32) * 128 + hi * 8;
#pragma unroll
  for (int d0 = 0; d0 < 8; ++d0) qr[d0] = St::ld8(Qw + d0 * 16);
  const int sr = tid >> 4, sc = (tid & 15) * 8, vst0 = v_st(sr, sc), vst1 = v_st(32 + sr, sc);
  const int vb = (int)(uintptr_t)V_lds + kh * 16384 + v_rd_base(lane);
  const int vbA = vb + 2 * kh * 4096, vbB = vb + 2 * (1 - kh) * 4096;
  const int krow = 32 * kh + r32;
  char* xw = X_lds + (wid * 64 + lane) * 32; const char* xr = X_lds + ((wid ^ 1) * 64 + lane) * 32;
  bf16x8 sk0, sk1, sv0, sv1, sv2, sv3;
#define KLOAD(k0) do { sk0 = St::ld8(&Kh[(long)((k0) + sr) * 128 + sc]); sk1 = St::ld8(&Kh[(long)((k0) + 32 + sr) * 128 + sc]); } while (0)
#define VLOAD(k0) do { sv0 = St::ld8(&Vh[(long)((k0) + sr) * 256 + sc]); sv1 = St::ld8(&Vh[(long)((k0) + 32 + sr) * 256 + sc]); \
    sv2 = St::ld8(&Vh[(long)((k0) + sr) * 256 + 128 + sc]); sv3 = St::ld8(&Vh[(long)((k0) + 32 + sr) * 256 + 128 + sc]); } while (0)
#define KWRITE(b) do { *(bf16x8*)(K_lds + (b) * 16384 + KSWZ(sr, sc * 2)) = sk0; *(bf16x8*)(K_lds + (b) * 16384 + KSWZ(32 + sr, sc * 2)) = sk1; } while (0)
#define VWRITE(b) do { *(bf16x8*)(V_lds + (b) * 32768 + vst0) = sv0; *(bf16x8*)(V_lds + (b) * 32768 + vst1) = sv1; \
    *(bf16x8*)(V_lds + (b) * 32768 + 16384 + vst0) = sv2; *(bf16x8*)(V_lds + (b) * 32768 + 16384 + vst1) = sv3; } while (0)
#define QKT(PE, PO, b) do { const char* Kb_ = K_lds + (b) * 16384; PE = f32x16{}; PO = f32x16{}; \
    _Pragma("unroll") for (int d0 = 0; d0 < 8; d0 += 2) { \
      const bf16x8 k0_ = *reinterpret_cast<const bf16x8*>(Kb_ + KSWZ(krow, (d0 * 16 + hi * 8) * 2)); \
      const bf16x8 k1_ = *reinterpret_cast<const bf16x8*>(Kb_ + KSWZ(krow, ((d0 + 1) * 16 + hi * 8) * 2)); \
      PE = __builtin_amdgcn_mfma_f32_32x32x16_bf16(k0_, qr[d0], PE, 0, 0, 0); \
      PO = __builtin_amdgcn_mfma_f32_32x32x16_bf16(k1_, qr[d0 + 1], PO, 0, 0, 0); } } while (0)
  const int NT = seq / KVBLK;
  KLOAD(0); VLOAD(0); KWRITE(0); VWRITE(0); KLOAD(KVBLK); KWRITE(1); KLOAD(2 * KVBLK); VLOAD(KVBLK); __syncthreads();
  f32x16 pe, po, pc;
  QKT(pe, po, 0);
#pragma unroll
  for (int r = 0; r < 16; ++r) pc[r] = pe[r] + po[r];
  for (int j = 0; j < NT; ++j) {
    const int buf = j & 1;
    SBAR();
    if (j + 1 < NT) { QKT(pe, po, buf ^ 1); }
    f32x16 p;
#pragma unroll
    for (int r = 0; r < 16; ++r) p[r] = __builtin_amdgcn_exp2f(fmaf(pc[r], C, negMc));
    float ps = 0.f;
#pragma unroll
    for (int r = 0; r < 16; ++r) ps += p[r];
    lsum += ps;
    const bf16x8 own0 = pk8(p, 0), own1 = pk8(p, 8);
    *(bf16x8*)(xw) = own0; *(bf16x8*)(xw + 16) = own1;
    const int vo = buf * 32768;
#pragma unroll
    for (int q_ = 0; q_ < 8; ++q_) { __builtin_amdgcn_sched_group_barrier(0x100, 1, 0); __builtin_amdgcn_sched_group_barrier(0x008, 1, 0); __builtin_amdgcn_sched_group_barrier(0x002, 9, 0); }
    SBAR();
    pv_pair<0, 1>(o[0], o[1], vbA + vo, own0, own1); pv_pair<2, 3>(o[2], o[3], vbA + vo, own0, own1);
    __syncthreads();
    const bf16x8 pt0 = *(const bf16x8*)(xr), pt1 = *(const bf16x8*)(xr + 16);
    if (j + 2 < NT) { KWRITE(buf); }
    if (j + 1 < NT) { VWRITE(buf ^ 1); }
    if (j + 3 < NT) { KLOAD((j + 3) * KVBLK); }
    if (j + 2 < NT) { VLOAD((j + 2) * KVBLK); }
    SBAR();
    pv_pair<0, 1>(o[0], o[1], vbB + vo, pt0, pt1); pv_pair<2, 3>(o[2], o[3], vbB + vo, pt0, pt1);
#pragma unroll
    for (int r = 0; r < 16; ++r) pc[r] = pe[r] + po[r];
    __syncthreads();
  }
#undef KLOAD
#undef VLOAD
#undef KWRITE
#undef VWRITE
#undef QKT
  L_lds[(wid * 2 + hi) * 32 + r32] = lsum;
  __syncthreads();
  float rli[16];
#pragma unroll
  for (int r = 0; r < 16; ++r) { const int row = crow(r, hi); const float* lp = L_lds + (g * 4) * 32 + row; rli[r] = __builtin_amdgcn_rcpf((lp[0] + lp[32]) + (lp[64] + lp[96])); }
  float* Ow = Ob + (long)(g * 32) * LDO + kh * 128;
#pragma unroll
  for (int r = 0; r < 16; ++r) { const int orow = crow(r, hi);
    for (int d0 = 0; d0 < 4; ++d0) { float* op = &Ow[(long)orow * LDO + d0 * 32 + r32];
      if (MODE == 0) *op = o[d0][r] * rli[r]; else *op = *op - lam * (o[d0][r] * rli[r]); } }
  asm volatile("s_waitcnt vmcnt(0)" ::: "memory"); __syncthreads();
}
template <int MODE>
__device__ __forceinline__ void attn_pair6_body(const bf16* __restrict__ Qb, const bf16* __restrict__ Kh, const bf16* __restrict__ Vh, float* Ob, int seq, char* lds, float lam, float negMc) {
  using St = Stage<bf16>;
  int tid_ = threadIdx.x; asm volatile("" : "+v"(tid_));
  const int tid = tid_, wid = tid >> 6, lane = tid & 63, r32 = lane & 31, hi = lane >> 5, g = wid >> 1, kh = wid & 1;
  char* K_lds = lds; char* V_lds = lds + 32768; char* X_lds = lds + 98304; float* L_lds = (float*)(lds + 114688);
  constexpr float C = SCALE * 1.4426950408889634f;
  f32x16 o[4] = {}; bf16x8 qr[8]; float lsum = 0.f;
  const bf16* Qw = Qb + (long)(g * 32 + r32) * 128 + hi * 8;
#pragma unroll
  for (int d0 = 0; d0 < 8; ++d0) qr[d0] = St::ld8(Qw + d0 * 16);
  const int sr = tid >> 4, sc = (tid & 15) * 8, vst0 = v_st(sr, sc), vst1 = v_st(32 + sr, sc);
  const int vb = (int)(uintptr_t)V_lds + kh * 16384 + v_rd_base(lane);
  const int vbA = vb + 2 * kh * 4096, vbB = vb + 2 * (1 - kh) * 4096;
  const int krow = 32 * kh + r32;
  char* xw = X_lds + (wid * 64 + lane) * 32; const char* xr = X_lds + ((wid ^ 1) * 64 + lane) * 32;
  typedef __attribute__((address_space(3))) unsigned lds_u32;
  const int wu = __builtin_amdgcn_readfirstlane(wid);
  long gk[2], gv[2];
#pragma unroll
  for (int c = 0; c < 2; ++c) { const int q = wu + 8 * c;
    const int r = 4 * q + (lane >> 4), pch = lane & 15; gk[c] = (long)r * 128 + ((pch ^ (r & 7)) * 8);
    const int st = 2 * q + (lane >> 5), kk = (st >> 2) * 8 + ((lane >> 2) & 7), k = (kk & ~0xC) | ((kk & 4) << 1) | ((kk & 8) >> 1), cc = (st & 3) * 32 + (lane & 3) * 8;
    gv[c] = (long)k * 256 + cc; }
#define DMA16(gp, lp) __builtin_amdgcn_global_load_lds((const unsigned*)(gp), (lds_u32*)(lp), 16, 0, 0)
#define STAGE(k0, bb) do { const bf16* kt_ = Kh + (long)(k0) * 128; const bf16* vt_ = Vh + (long)(k0) * 256; \
    DMA16(kt_ + gk[0], K_lds + (bb) * 16384 + wu * 1024); DMA16(kt_ + gk[1], K_lds + (bb) * 16384 + (wu + 8) * 1024); \
    DMA16(vt_ + gv[0], V_lds + (bb) * 32768 + wu * 1024); DMA16(vt_ + gv[1], V_lds + (bb) * 32768 + (wu + 8) * 1024); \
    DMA16(vt_ + gv[0] + 128, V_lds + (bb) * 32768 + 16384 + wu * 1024); DMA16(vt_ + gv[1] + 128, V_lds + (bb) * 32768 + 16384 + (wu + 8) * 1024); } while (0)
#define RAWBAR() do { asm volatile("s_waitcnt lgkmcnt(0)" ::: "memory"); __builtin_amdgcn_s_barrier(); asm volatile("" ::: "memory"); } while (0)
  const int NT = seq / KVBLK;
  STAGE(0, 0); asm volatile("s_waitcnt vmcnt(0)" ::: "memory"); RAWBAR();
  for (int j = 0; j < NT; ++j) {
    const int buf = j & 1;
    if (j + 1 < NT) { STAGE((j + 1) * KVBLK, buf ^ 1); }
    const char* Kb = K_lds + buf * 16384;
    f32x16 pe = {}, po = {};
#pragma unroll
    for (int d0 = 0; d0 < 8; d0 += 2) {
      const bf16x8 k0 = *reinterpret_cast<const bf16x8*>(Kb + KSWZ(krow, (d0 * 16 + hi * 8) * 2));
      const bf16x8 k1 = *reinterpret_cast<const bf16x8*>(Kb + KSWZ(krow, ((d0 + 1) * 16 + hi * 8) * 2));
      pe = __builtin_amdgcn_mfma_f32_32x32x16_bf16(k0, qr[d0], pe, 0, 0, 0);
      po = __builtin_amdgcn_mfma_f32_32x32x16_bf16(k1, qr[d0 + 1], po, 0, 0, 0); }
    f32x16 p;
#pragma unroll
    for (int r = 0; r < 16; ++r) p[r] = __builtin_amdgcn_exp2f(fmaf(pe[r] + po[r], C, negMc));
    float ps = 0.f;
#pragma unroll
    for (int r = 0; r < 16; ++r) ps += p[r];
    lsum += ps;
    const bf16x8 own0 = pk8(p, 0), own1 = pk8(p, 8);
    *(bf16x8*)(xw) = own0; *(bf16x8*)(xw + 16) = own1;
    const int vo = buf * 32768;
    SBAR();
    pv_pair<0, 1>(o[0], o[1], vbA + vo, own0, own1); pv_pair<2, 3>(o[2], o[3], vbA + vo, own0, own1);
    RAWBAR();
    const bf16x8 pt0 = *(const bf16x8*)(xr), pt1 = *(const bf16x8*)(xr + 16);
    SBAR();
    pv_pair<0, 1>(o[0], o[1], vbB + vo, pt0, pt1); pv_pair<2, 3>(o[2], o[3], vbB + vo, pt0, pt1);
    asm volatile("s_waitcnt vmcnt(0)" ::: "memory");
    RAWBAR();
  }
#undef DMA16
#undef STAGE
#undef RAWBAR
  L_lds[(wid * 2 + hi) * 32 + r32] = lsum;
  __syncthreads();
  float rli[16];
#pragma unroll
  for (int r = 0; r < 16; ++r) { const int row = crow(r, hi); const float* lp = L_lds + (g * 4) * 32 + row; rli[r] = __builtin_amdgcn_rcpf((lp[0] + lp[32]) + (lp[64] + lp[96])); }
  float* Ow = Ob + (long)(g * 32) * LDO + kh * 128;
#pragma unroll
  for (int r = 0; r < 16; ++r) { const int orow = crow(r, hi);
    for (int d0 = 0; d0 < 4; ++d0) { float* op = &Ow[(long)orow * LDO + d0 * 32 + r32];
      if (MODE == 0) *op = o[d0][r] * rli[r]; else *op = *op - lam * (o[d0][r] * rli[r]); } }
  asm volatile("s_waitcnt vmcnt(0)" ::: "memory"); __syncthreads();
}
template <int MODE>
__device__ __forceinline__ void attn_pair7_body(const bf16* __restrict__ Qb, const bf16* __restrict__ Kh, const bf16* __restrict__ Vh, float* Ob, int seq, char* lds, float lam, float negMc) {
  using St = Stage<bf16>;
  int tid_ = threadIdx.x; asm volatile("" : "+v"(tid_));
  const int tid = tid_, wid = tid >> 6, lane = tid & 63, r32 = lane & 31, hi = lane >> 5, g = wid >> 1, kh = wid & 1;
  char* K_lds = lds; char* V_lds = lds + 32768; char* X_lds = lds + 98304; float* L_lds = (float*)(lds + 131072);
  constexpr float C = SCALE * 1.4426950408889634f;
  f32x16 o[4] = {}; bf16x8 qr[8]; float lsum = 0.f;
  const bf16* Qw = Qb + (long)(g * 32 + r32) * 128 + hi * 8;
#pragma unroll
  for (int d0 = 0; d0 < 8; ++d0) qr[d0] = St::ld8(Qw + d0 * 16);
  const int sr = tid >> 4, sc = (tid & 15) * 8, vst0 = v_st(sr, sc), vst1 = v_st(32 + sr, sc);
  const int vb = (int)(uintptr_t)V_lds + kh * 16384 + v_rd_base(lane);
  const int vbA = vb + 2 * kh * 4096, vbB = vb + 2 * (1 - kh) * 4096;
  const int krow = 32 * kh + r32;
  char* xw = X_lds + (wid * 64 + lane) * 32; const char* xr = X_lds + ((wid ^ 1) * 64 + lane) * 32;
  typedef __attribute__((address_space(3))) unsigned lds_u32;
  const int wu = __builtin_amdgcn_readfirstlane(wid);
  long gk[2], gv[2];
#pragma unroll
  for (int c = 0; c < 2; ++c) { const int q = wu + 8 * c;
    const int r = 4 * q + (lane >> 4), pch = lane & 15; gk[c] = (long)r * 128 + ((pch ^ (r & 7)) * 8);
    const int st = 2 * q + (lane >> 5), kk = (st >> 2) * 8 + ((lane >> 2) & 7), k = (kk & ~0xC) | ((kk & 4) << 1) | ((kk & 8) >> 1), cc = (st & 3) * 32 + (lane & 3) * 8;
    gv[c] = (long)k * 256 + cc; }
#define DMA16(gp, lp) __builtin_amdgcn_global_load_lds((const unsigned*)(gp), (lds_u32*)(lp), 16, 0, 0)
#define STAGE_K(k0, bb) do { const bf16* kt_ = Kh + (long)(k0) * 128; \
    DMA16(kt_ + gk[0], K_lds + (bb) * 16384 + wu * 1024); DMA16(kt_ + gk[1], K_lds + (bb) * 16384 + (wu + 8) * 1024); } while (0)
#define STAGE_V(k0, bb) do { const bf16* vt_ = Vh + (long)(k0) * 256; \
    DMA16(vt_ + gv[0], V_lds + (bb) * 32768 + wu * 1024); DMA16(vt_ + gv[1], V_lds + (bb) * 32768 + (wu + 8) * 1024); \
    DMA16(vt_ + gv[0] + 128, V_lds + (bb) * 32768 + 16384 + wu * 1024); DMA16(vt_ + gv[1] + 128, V_lds + (bb) * 32768 + 16384 + (wu + 8) * 1024); } while (0)
#define RAWBAR() do { asm volatile("s_waitcnt lgkmcnt(0)" ::: "memory"); __builtin_amdgcn_s_barrier(); asm volatile("" ::: "memory"); } while (0)
#define QKT(PE, PO, b) do { const char* Kb_ = K_lds + (b) * 16384; PE = f32x16{}; PO = f32x16{}; \
    _Pragma("unroll") for (int d0 = 0; d0 < 8; d0 += 2) { \
      const bf16x8 k0_ = *reinterpret_cast<const bf16x8*>(Kb_ + KSWZ(krow, (d0 * 16 + hi * 8) * 2)); \
      const bf16x8 k1_ = *reinterpret_cast<const bf16x8*>(Kb_ + KSWZ(krow, ((d0 + 1) * 16 + hi * 8) * 2)); \
      PE = __builtin_amdgcn_mfma_f32_32x32x16_bf16(k0_, qr[d0], PE, 0, 0, 0); \
      PO = __builtin_amdgcn_mfma_f32_32x32x16_bf16(k1_, qr[d0 + 1], PO, 0, 0, 0); } } while (0)
#define SMX(R0) do { _Pragma("unroll") for (int r = (R0); r < (R0) + 4; ++r) { p[r] = __builtin_amdgcn_exp2f(fmaf(pe[r] + po[r], C, negMc)); lsum += p[r]; } } while (0)
  const int NT = seq / KVBLK;
  char* xw0 = xw; const char* xr0 = xr;
  f32x16 pe, po, p; bf16x8 own0, own1;
  STAGE_K(0, 0); STAGE_V(0, 0); STAGE_K(KVBLK, 1); asm volatile("s_waitcnt vmcnt(0)" ::: "memory"); RAWBAR();
  QKT(pe, po, 0); SMX(0); SMX(4); SMX(8); SMX(12);
  own0 = pk8(p, 0); own1 = pk8(p, 8);
  *(bf16x8*)(xw0) = own0; *(bf16x8*)(xw0 + 16) = own1;
  RAWBAR();
  for (int j = 0; j < NT; ++j) {
    const int buf = j & 1; const bool more = j + 1 < NT;
    if (j + 2 < NT) { STAGE_K((j + 2) * KVBLK, buf); }
    if (more)       { STAGE_V((j + 1) * KVBLK, buf ^ 1); }
    const bf16x8 pt0 = *(const bf16x8*)(xr0 + buf * 16384), pt1 = *(const bf16x8*)(xr0 + buf * 16384 + 16);
    const bf16x8 cur0 = own0, cur1 = own1;
    if (more) { QKT(pe, po, buf ^ 1); }
    const int vo = buf * 32768;
    SBAR();
    pv_pair<0, 1>(o[0], o[1], vbA + vo, cur0, cur1); if (more) SMX(0);
    pv_pair<2, 3>(o[2], o[3], vbA + vo, cur0, cur1); if (more) SMX(4);
    pv_pair<0, 1>(o[0], o[1], vbB + vo, pt0, pt1);   if (more) SMX(8);
    pv_pair<2, 3>(o[2], o[3], vbB + vo, pt0, pt1);   if (more) SMX(12);
    if (more) { own0 = pk8(p, 0); own1 = pk8(p, 8);
      *(bf16x8*)(xw0 + (buf ^ 1) * 16384) = own0; *(bf16x8*)(xw0 + (buf ^ 1) * 16384 + 16) = own1; }
    asm volatile("s_waitcnt vmcnt(0)" ::: "memory");
    RAWBAR();
  }
#undef DMA16
#undef STAGE_K
#undef STAGE_V
#undef RAWBAR
#undef QKT
#undef SMX
  L_lds[(wid * 2 + hi) * 32 + r32] = lsum;
  __syncthreads();
  float rli[16];
#pragma unroll
  for (int r = 0; r < 16; ++r) { const int row = crow(r, hi); const float* lp = L_lds + (g * 4) * 32 + row; rli[r] = __builtin_amdgcn_rcpf((lp[0] + lp[32]) + (lp[64] + lp[96])); }
  float* Ow = Ob + (long)(g * 32) * LDO + kh * 128;
#pragma unroll
  for (int r = 0; r < 16; ++r) { const int orow = crow(r, hi);
    for (int d0 = 0; d0 < 4; ++d0) { float* op = &Ow[(long)orow * LDO + d0 * 32 + r32];
      if (MODE == 0) *op = o[d0][r] * rli[r]; else *op = *op - lam * (o[d0][r] * rli[r]); } }
  asm volatile("s_waitcnt vmcnt(0)" ::: "memory"); __syncthreads();
}
template <int MODE>
__device__ __forceinline__ void attn_pair8_body(const bf16* __restrict__ Qb, const bf16* __restrict__ Kh, const bf16* __restrict__ Vh, unsigned (&o0)[4][8], unsigned short* A2w, const unsigned short* Gw, const float* subw, int seq, char* lds, float lam, float negMc) {
  using St = Stage<bf16>;
  int tid_ = threadIdx.x; asm volatile("" : "+v"(tid_));
  const int tid = tid_, wid = tid >> 6, lane = tid & 63, r32 = lane & 31, hi = lane >> 5, g = wid >> 1, kh = wid & 1;
  char* K_lds = lds; char* V_lds = lds + 32768; char* X_lds = lds + 98304; float* L_lds = (float*)(lds + 114688);
  constexpr float C = SCALE * 1.4426950408889634f;
  f32x16 o[4] = {}; bf16x8 qr[8]; float lsum = 0.f;
  const bf16* Qw = Qb + (long)(g * 32 + r32) * 128 + hi * 8;
#pragma unroll
  for (int d0 = 0; d0 < 8; ++d0) qr[d0] = St::ld8(Qw + d0 * 16);
  const int sr = tid >> 4, sc = (tid & 15) * 8, vst0 = v_st(sr, sc), vst1 = v_st(32 + sr, sc);
  const int vb = (int)(uintptr_t)V_lds + kh * 16384 + v_rd_base(lane);
  const int vbA = vb + 2 * kh * 4096, vbB = vb + 2 * (1 - kh) * 4096;
  const int krow = 32 * kh + r32;
  char* xw = X_lds + (wid * 64 + lane) * 32; const char* xr = X_lds + ((wid ^ 1) * 64 + lane) * 32;
  typedef __attribute__((address_space(3))) unsigned lds_u32;
  const int wu = __builtin_amdgcn_readfirstlane(wid);
  long gk[2], gv[2];
#pragma unroll
  for (int c = 0; c < 2; ++c) { const int q = wu + 8 * c;
    const int r = 4 * q + (lane >> 4), pch = lane & 15; gk[c] = (long)r * 128 + ((pch ^ (r & 7)) * 8);
    const int st = 2 * q + (lane >> 5), kk = (st >> 2) * 8 + ((lane >> 2) & 7), k = (kk & ~0xC) | ((kk & 4) << 1) | ((kk & 8) >> 1), cc = (st & 3) * 32 + (lane & 3) * 8;
    gv[c] = (long)k * 256 + cc; }
#define DMA16(gp, lp) __builtin_amdgcn_global_load_lds((const unsigned*)(gp), (lds_u32*)(lp), 16, 0, 0)
#define STAGE(k0, bb) do { const bf16* kt_ = Kh + (long)(k0) * 128; const bf16* vt_ = Vh + (long)(k0) * 256; \
    DMA16(kt_ + gk[0], K_lds + (bb) * 16384 + wu * 1024); DMA16(kt_ + gk[1], K_lds + (bb) * 16384 + (wu + 8) * 1024); \
    DMA16(vt_ + gv[0], V_lds + (bb) * 32768 + wu * 1024); DMA16(vt_ + gv[1], V_lds + (bb) * 32768 + (wu + 8) * 1024); \
    DMA16(vt_ + gv[0] + 128, V_lds + (bb) * 32768 + 16384 + wu * 1024); DMA16(vt_ + gv[1] + 128, V_lds + (bb) * 32768 + 16384 + (wu + 8) * 1024); } while (0)
#define RAWBAR() do { asm volatile("s_waitcnt lgkmcnt(0)" ::: "memory"); __builtin_amdgcn_s_barrier(); asm volatile("" ::: "memory"); } while (0)
  const int NT = seq / KVBLK;
  STAGE(0, 0); asm volatile("s_waitcnt vmcnt(0)" ::: "memory"); RAWBAR();
  for (int j = 0; j < NT; ++j) {
    const int buf = j & 1;
    if (j + 1 < NT) { STAGE((j + 1) * KVBLK, buf ^ 1); }
    const char* Kb = K_lds + buf * 16384;
    f32x16 pe = {}, po = {};
#pragma unroll
    for (int d0 = 0; d0 < 8; d0 += 2) {
      const bf16x8 k0 = *reinterpret_cast<const bf16x8*>(Kb + KSWZ(krow, (d0 * 16 + hi * 8) * 2));
      const bf16x8 k1 = *reinterpret_cast<const bf16x8*>(Kb + KSWZ(krow, ((d0 + 1) * 16 + hi * 8) * 2));
      pe = __builtin_amdgcn_mfma_f32_32x32x16_bf16(k0, qr[d0], pe, 0, 0, 0);
      po = __builtin_amdgcn_mfma_f32_32x32x16_bf16(k1, qr[d0 + 1], po, 0, 0, 0); }
    f32x16 p;
#pragma unroll
    for (int r = 0; r < 16; ++r) p[r] = __builtin_amdgcn_exp2f(fmaf(pe[r] + po[r], C, negMc));
    float ps = 0.f;
#pragma unroll
    for (int r = 0; r < 16; ++r) ps += p[r];
    lsum += ps;
    const bf16x8 own0 = pk8(p, 0), own1 = pk8(p, 8);
    *(bf16x8*)(xw) = own0; *(bf16x8*)(xw + 16) = own1;
    const int vo = buf * 32768;
    SBAR();
    pv_pair<0, 1>(o[0], o[1], vbA + vo, own0, own1); pv_pair<2, 3>(o[2], o[3], vbA + vo, own0, own1);
    RAWBAR();
    const bf16x8 pt0 = *(const bf16x8*)(xr), pt1 = *(const bf16x8*)(xr + 16);
    SBAR();
    pv_pair<0, 1>(o[0], o[1], vbB + vo, pt0, pt1); pv_pair<2, 3>(o[2], o[3], vbB + vo, pt0, pt1);
    asm volatile("s_waitcnt vmcnt(0)" ::: "memory");
    RAWBAR();
  }
#undef DMA16
#undef STAGE
#undef RAWBAR
  L_lds[(wid * 2 + hi) * 32 + r32] = lsum;
  __syncthreads();
  float rli[16];
#pragma unroll
  for (int r = 0; r < 16; ++r) { const int row = crow(r, hi); const float* lp = L_lds + (g * 4) * 32 + row; rli[r] = __builtin_amdgcn_rcpf((lp[0] + lp[32]) + (lp[64] + lp[96])); }
  if (MODE == 0) {
#pragma unroll
    for (int d0 = 0; d0 < 4; ++d0)
#pragma unroll
      for (int r = 0; r < 16; r += 2) o0[d0][r >> 1] = cvtpk(o[d0][r] * rli[r], o[d0][r + 1] * rli[r + 1]);
    __syncthreads();
  } else {
    float ssq[16];
#pragma unroll
    for (int r = 0; r < 16; ++r) { float s = 0.f;
#pragma unroll
      for (int d0 = 0; d0 < 4; ++d0) { const unsigned w_ = o0[d0][r >> 1]; const float v = __builtin_bit_cast(float, (r & 1) ? (w_ & 0xffff0000u) : (w_ << 16)) - lam * (o[d0][r] * rli[r]); o[d0][r] = v; s += v * v; }
      s += __shfl_xor(s, 1); s += __shfl_xor(s, 2); s += __shfl_xor(s, 4); s += __shfl_xor(s, 8); s += __shfl_xor(s, 16);
      ssq[r] = s; }
    __syncthreads();
    if (r32 == 0) {
#pragma unroll
      for (int r = 0; r < 16; ++r) L_lds[wid * 32 + crow(r, hi)] = ssq[r]; }
    __syncthreads();
    constexpr float ONE_M_LI = 1.f - 0.35550906759f;
    float sw[4];
#pragma unroll
    for (int d0 = 0; d0 < 4; ++d0) sw[d0] = subw[kh * 128 + d0 * 32 + r32] * ONE_M_LI;
    char* zt = lds + wid * 8704;
#pragma unroll
    for (int r = 0; r < 16; ++r) { const int orow = crow(r, hi);
      const float rstd = rsqrtf((L_lds[wid * 32 + orow] + L_lds[(wid ^ 1) * 32 + orow]) * (1.f / 256.f) + 1e-6f);
#pragma unroll
      for (int d0 = 0; d0 < 4; ++d0) { const float z = o[d0][r] * rstd * sw[d0];
        *(unsigned short*)(zt + orow * 272 + (d0 * 32 + r32) * 2) = (unsigned short)(cvtpk(z, z) & 0xffffu); } }
    asm volatile("s_waitcnt lgkmcnt(0)" ::: "memory");
    u32x4 gq[8];
#pragma unroll
    for (int i = 0; i < 8; ++i) { const int id = lane + 64 * i; gq[i] = *(const u32x4*)(Gw + (long)(g * 32 + (id >> 4)) * 2048 + kh * 128 + (id & 15) * 8); }
#pragma unroll
    for (int i = 0; i < 8; ++i) { const int id = lane + 64 * i, row = id >> 4, cc = id & 15;
      const u32x4 zz = *(const u32x4*)(zt + row * 272 + cc * 16);
      unsigned yo[4];
#pragma unroll
      for (int k = 0; k < 4; ++k) { const unsigned zw = zz[k], gw_ = gq[i][k];
        const float z0 = __builtin_bit_cast(float, zw << 16), z1 = __builtin_bit_cast(float, zw & 0xffff0000u);
        const float g0 = __builtin_bit_cast(float, gw_ << 16), g1 = __builtin_bit_cast(float, gw_ & 0xffff0000u);
        yo[k] = cvtpk(z0 * (g0 / (1.f + __expf(-g0))), z1 * (g1 / (1.f + __expf(-g1)))); }
      *(u32x4*)(A2w + (long)(g * 32 + row) * 2048 + kh * 128 + cc * 8) = (u32x4){yo[0], yo[1], yo[2], yo[3]}; }
    asm volatile("s_waitcnt vmcnt(0)" ::: "memory"); __syncthreads();
  }
}
template <int MODE>
__device__ __forceinline__ void attn_pair9_body(const bf16* __restrict__ Qb, const bf16* __restrict__ Kh, const bf16* __restrict__ Vh, unsigned (&o0)[4][8], unsigned short* A2w, const unsigned short* Gw, const float* subw, int seq, char* lds, float lam, float negMc) {
  using St = Stage<bf16>;
  int tid_ = threadIdx.x; asm volatile("" : "+v"(tid_));
  const int tid = tid_, wid = tid >> 6, lane = tid & 63, r32 = lane & 31, hi = lane >> 5, g = wid >> 1, kh = wid & 1;
  char* K_lds = lds; char* V_lds = lds + 32768; char* X_lds = lds + 98304; float* L_lds = (float*)(lds + 114688);
  constexpr float C = SCALE * 1.4426950408889634f;
  f32x16 o[4] = {}; bf16x8 qr[8]; float lsum = 0.f;
  const bf16* Qw = Qb + (long)(g * 32 + r32) * 128 + hi * 8;
#pragma unroll
  for (int d0 = 0; d0 < 8; ++d0) qr[d0] = St::ld8(Qw + d0 * 16);
  const int sr = tid >> 4, sc = (tid & 15) * 8, vst0 = v_st(sr, sc), vst1 = v_st(32 + sr, sc);
  const int vb = (int)(uintptr_t)V_lds + kh * 16384 + v_rd_base(lane);
  const int vbA = vb + 2 * kh * 4096, vbB = vb + 2 * (1 - kh) * 4096;
  const int krow = 32 * kh + r32;
  char* xw = X_lds + (wid * 64 + lane) * 32; const char* xr = X_lds + ((wid ^ 1) * 64 + lane) * 32;
  typedef __attribute__((address_space(3))) unsigned lds_u32;
  const int wu = __builtin_amdgcn_readfirstlane(wid);
  const bool early = wu < 4; const int w4 = wu & 3;
  long gk[4], gv[4];
#pragma unroll
  for (int c = 0; c < 4; ++c) { const int q = w4 + 4 * c;
    const int r = 4 * q + (lane >> 4), pch = lane & 15; gk[c] = (long)r * 128 + ((pch ^ (r & 7)) * 8);
    const int st = 2 * q + (lane >> 5), kk = (st >> 2) * 8 + ((lane >> 2) & 7), k = (kk & ~0xC) | ((kk & 4) << 1) | ((kk & 8) >> 1), cc = (st & 3) * 32 + (lane & 3) * 8;
    gv[c] = (long)k * 256 + cc; }
#define DMA16(gp, lp) __builtin_amdgcn_global_load_lds((const unsigned*)(gp), (lds_u32*)(lp), 16, 0, 0)
#define STAGE_K(k0, bb) do { const bf16* kt_ = Kh + (long)(k0) * 128; \
    _Pragma("unroll") for (int c = 0; c < 4; ++c) DMA16(kt_ + gk[c], K_lds + (bb) * 16384 + (w4 + 4 * c) * 1024); } while (0)
#define STAGE_V(k0, bb) do { const bf16* vt_ = Vh + (long)(k0) * 256; \
    _Pragma("unroll") for (int c = 0; c < 4; ++c) { DMA16(vt_ + gv[c], V_lds + (bb) * 32768 + (w4 + 4 * c) * 1024); DMA16(vt_ + gv[c] + 128, V_lds + (bb) * 32768 + 16384 + (w4 + 4 * c) * 1024); } } while (0)
#define RAWBAR() do { asm volatile("s_waitcnt lgkmcnt(0)" ::: "memory"); __builtin_amdgcn_s_barrier(); asm volatile("" ::: "memory"); } while (0)
  const int NT = seq / KVBLK;
  if (early) { STAGE_V(0, 0); } else { STAGE_K(0, 0); STAGE_K(KVBLK, 1); }
  asm volatile("s_waitcnt vmcnt(0)" ::: "memory"); RAWBAR();
  if (!early) RAWBAR();
  if (!early) __builtin_amdgcn_s_setprio(1);
  bf16x8 own0, own1;
  for (int j = 0; j < NT; ++j) {
    const int buf = j & 1;
    { const char* Kb = K_lds + buf * 16384;
      f32x16 pe = {}, po = {};
#pragma unroll
      for (int d0 = 0; d0 < 8; d0 += 2) {
        const bf16x8 k0 = *reinterpret_cast<const bf16x8*>(Kb + KSWZ(krow, (d0 * 16 + hi * 8) * 2));
        const bf16x8 k1 = *reinterpret_cast<const bf16x8*>(Kb + KSWZ(krow, ((d0 + 1) * 16 + hi * 8) * 2));
        pe = __builtin_amdgcn_mfma_f32_32x32x16_bf16(k0, qr[d0], pe, 0, 0, 0);
        po = __builtin_amdgcn_mfma_f32_32x32x16_bf16(k1, qr[d0 + 1], po, 0, 0, 0); }
      f32x16 p;
#pragma unroll
      for (int r = 0; r < 16; ++r) p[r] = __builtin_amdgcn_exp2f(fmaf(pe[r] + po[r], C, negMc));
      float ps = 0.f;
#pragma unroll
      for (int r = 0; r < 16; ++r) ps += p[r];
      lsum += ps;
      own0 = pk8(p, 0); own1 = pk8(p, 8);
      *(bf16x8*)(xw) = own0; *(bf16x8*)(xw + 16) = own1; }
    asm volatile("s_waitcnt vmcnt(0)" ::: "memory");
    RAWBAR();
    if (early) { if (j + 1 < NT) { STAGE_V((j + 1) * KVBLK, buf ^ 1); } }
    else       { if (j + 2 < NT) { STAGE_K((j + 2) * KVBLK, buf); } }
    const bf16x8 pt0 = *(const bf16x8*)(xr), pt1 = *(const bf16x8*)(xr + 16);
    const int vo = buf * 32768;
    SBAR();
    pv_pair_np<0, 1>(o[0], o[1], vbA + vo, own0, own1); pv_pair_np<2, 3>(o[2], o[3], vbA + vo, own0, own1);
    pv_pair_np<0, 1>(o[0], o[1], vbB + vo, pt0, pt1); pv_pair_np<2, 3>(o[2], o[3], vbB + vo, pt0, pt1);
    RAWBAR();
  }
  __builtin_amdgcn_s_setprio(0);
  if (early) RAWBAR();
#undef DMA16
#undef STAGE_K
#undef STAGE_V
#undef RAWBAR
  L_lds[(wid * 2 + hi) * 32 + r32] = lsum;
  __syncthreads();
  float rli[16];
#pragma unroll
  for (int r = 0; r < 16; ++r) { const int row = crow(r, hi); const float* lp = L_lds + (g * 4) * 32 + row; rli[r] = __builtin_amdgcn_rcpf((lp[0] + lp[32]) + (lp[64] + lp[96])); }
  if (MODE == 0) {
#pragma unroll
    for (int d0 = 0; d0 < 4; ++d0)
#pragma unroll
      for (int r = 0; r < 16; r += 2) o0[d0][r >> 1] = cvtpk(o[d0][r] * rli[r], o[d0][r + 1] * rli[r + 1]);
    __syncthreads();
  } else {
    float ssq[16];
#pragma unroll
    for (int r = 0; r < 16; ++r) { float s = 0.f;
#pragma unroll
      for (int d0 = 0; d0 < 4; ++d0) { const unsigned w_ = o0[d0][r >> 1]; const float v = __builtin_bit_cast(float, (r & 1) ? (w_ & 0xffff0000u) : (w_ << 16)) - lam * (o[d0][r] * rli[r]); o[d0][r] = v; s += v * v; }
      s += __shfl_xor(s, 1); s += __shfl_xor(s, 2); s += __shfl_xor(s, 4); s += __shfl_xor(s, 8); s += __shfl_xor(s, 16);
      ssq[r] = s; }
    __syncthreads();
    if (r32 == 0) {
#pragma unroll
      for (int r = 0; r < 16; ++r) L_lds[wid * 32 + crow(r, hi)] = ssq[r]; }
    __syncthreads();
    constexpr float ONE_M_LI = 1.f - 0.35550906759f;
    float sw[4];
#pragma unroll
    for (int d0 = 0; d0 < 4; ++d0) sw[d0] = subw[kh * 128 + d0 * 32 + r32] * ONE_M_LI;
    char* zt = lds + wid * 8704;
#pragma unroll
    for (int r = 0; r < 16; ++r) { const int orow = crow(r, hi);
      const float rstd = rsqrtf((L_lds[wid * 32 + orow] + L_lds[(wid ^ 1) * 32 + orow]) * (1.f / 256.f) + 1e-6f);
#pragma unroll
      for (int d0 = 0; d0 < 4; ++d0) { const float z = o[d0][r] * rstd * sw[d0];
        *(unsigned short*)(zt + orow * 272 + (d0 * 32 + r32) * 2) = (unsigned short)(cvtpk(z, z) & 0xffffu); } }
    asm volatile("s_waitcnt lgkmcnt(0)" ::: "memory");
    u32x4 gq[8];
#pragma unroll
    for (int i = 0; i < 8; ++i) { const int id = lane + 64 * i; gq[i] = *(const u32x4*)(Gw + (long)(g * 32 + (id >> 4)) * 2048 + kh * 128 + (id & 15) * 8); }
#pragma unroll
    for (int i = 0; i < 8; ++i) { const int id = lane + 64 * i, row = id >> 4, cc = id & 15;
      const u32x4 zz = *(const u32x4*)(zt + row * 272 + cc * 16);
      unsigned yo[4];
#pragma unroll
      for (int k = 0; k < 4; ++k) { const unsigned zw = zz[k], gw_ = gq[i][k];
        const float z0 = __builtin_bit_cast(float, zw << 16), z1 = __builtin_bit_cast(float, zw & 0xffff0000u);
        const float g0 = __builtin_bit_cast(float, gw_ << 16), g1 = __builtin_bit_cast(float, gw_ & 0xffff0000u);
        yo[k] = cvtpk(z0 * (g0 / (1.f + __expf(-g0))), z1 * (g1 / (1.f + __expf(-g1)))); }
      *(u32x4*)(A2w + (long)(g * 32 + row) * 2048 + kh * 128 + cc * 8) = (u32x4){yo[0], yo[1], yo[2], yo[3]}; }
    asm volatile("s_waitcnt vmcnt(0)" ::: "memory"); __syncthreads();
  }
}
template <int MODE>
__device__ __forceinline__ void attn_ks_body(const bf16* __restrict__ Qb, const bf16* __restrict__ Kh, const bf16* __restrict__ Vh, float* Ob, unsigned short* A2w, const unsigned short* Gw, const float* subw,
                                             int seq, char* lds, float lam, float negMc) {
  using St = Stage<bf16>;
  int tid_ = threadIdx.x; asm volatile("" : "+v"(tid_));
  const int tid = tid_, wid = tid >> 6, lane = tid & 63, r32 = lane & 31, hi = lane >> 5, g = wid >> 1, kh = wid & 1;
  char* K_lds = lds; char* V_lds = lds + 32768; float* L_lds = (float*)(lds + 131072);
  constexpr float C = SCALE * 1.4426950408889634f;
  f32x16 o[8] = {}; bf16x8 qr[8]; float lsum = 0.f;
  const bf16* Qw = Qb + (long)(g * 32 + r32) * 128 + hi * 8;
#pragma unroll
  for (int d0 = 0; d0 < 8; ++d0) qr[d0] = St::ld8(Qw + d0 * 16);
  const int vb0 = (int)(uintptr_t)V_lds + v_rd_base(lane) + 2 * kh * 4096;
  const int krow = 32 * kh + r32;
  typedef __attribute__((address_space(3))) unsigned lds_u32;
  const int wu = __builtin_amdgcn_readfirstlane(wid);
  long gk[2], gv[2];
#pragma unroll
  for (int c = 0; c < 2; ++c) { const int q = wu + 8 * c;
    const int r = 4 * q + (lane >> 4), pch = lane & 15; gk[c] = (long)r * 128 + ((pch ^ (r & 7)) * 8);
    const int st = 2 * q + (lane >> 5), kk = (st >> 2) * 8 + ((lane >> 2) & 7), k = (kk & ~0xC) | ((kk & 4) << 1) | ((kk & 8) >> 1), cc = (st & 3) * 32 + (lane & 3) * 8;
    gv[c] = (long)k * 256 + cc; }
#define DMA16(gp, lp) __builtin_amdgcn_global_load_lds((const unsigned*)(gp), (lds_u32*)(lp), 16, 0, 0)
#define STAGE(k0, bb) do { const bf16* kt_ = Kh + (long)(k0) * 128; const bf16* vt_ = Vh + (long)(k0) * 256; \
    DMA16(kt_ + gk[0], K_lds + (bb) * 16384 + wu * 1024); DMA16(kt_ + gk[1], K_lds + (bb) * 16384 + (wu + 8) * 1024); \
    DMA16(vt_ + gv[0], V_lds + (bb) * 32768 + wu * 1024); DMA16(vt_ + gv[1], V_lds + (bb) * 32768 + (wu + 8) * 1024); \
    DMA16(vt_ + gv[0] + 128, V_lds + (bb) * 32768 + 16384 + wu * 1024); DMA16(vt_ + gv[1] + 128, V_lds + (bb) * 32768 + 16384 + (wu + 8) * 1024); } while (0)
#define RAWBAR() do { asm volatile("s_waitcnt lgkmcnt(0)" ::: "memory"); __builtin_amdgcn_s_barrier(); asm volatile("" ::: "memory"); } while (0)
  const int NT = seq / KVBLK;
  STAGE(0, 0); asm volatile("s_waitcnt vmcnt(0)" ::: "memory"); RAWBAR();
  if (false) __builtin_amdgcn_s_setprio(1);
  for (int j = 0; j < NT; ++j) {
    const int buf = j & 1;
    if (j + 1 < NT) { STAGE((j + 1) * KVBLK, buf ^ 1); }
    const char* Kb = K_lds + buf * 16384;
    f32x16 pe = {}, po = {};
#pragma unroll
    for (int d0 = 0; d0 < 8; d0 += 2) {
      const bf16x8 k0 = *reinterpret_cast<const bf16x8*>(Kb + KSWZ(krow, (d0 * 16 + hi * 8) * 2));
      const bf16x8 k1 = *reinterpret_cast<const bf16x8*>(Kb + KSWZ(krow, ((d0 + 1) * 16 + hi * 8) * 2));
      pe = __builtin_amdgcn_mfma_f32_32x32x16_bf16(k0, qr[d0], pe, 0, 0, 0);
      po = __builtin_amdgcn_mfma_f32_32x32x16_bf16(k1, qr[d0 + 1], po, 0, 0, 0); }
    const int vo = vb0 + buf * 32768;
    s16x4 R0_[8], R1_[8];
    PVR(R0_, 0, 1, vo);
    f32x16 p;
#pragma unroll
    for (int r = 0; r < 16; ++r) p[r] = __builtin_amdgcn_exp2f(fmaf(pe[r] + po[r], C, negMc));
    float ps = 0.f;
#pragma unroll
    for (int r = 0; r < 16; ++r) ps += p[r];
    lsum += ps;
    const bf16x8 own0 = pk8(p, 0), own1 = pk8(p, 8);
    SBAR();
    PV_TAIL4(o, vo, vo + 16384, own0, own1);
    asm volatile("s_waitcnt vmcnt(0)" ::: "memory");
    RAWBAR();
  }
#undef DMA16
#undef STAGE
#undef RAWBAR
  __builtin_amdgcn_s_setprio(0);
  L_lds[(wid * 2 + hi) * 32 + r32] = lsum;
#define XS_WRITE(OV, BASE) do { float* xs_ = (float*)(lds + (BASE)) + ((g * 4) * 64 + lane) * 16; \
    _Pragma("unroll") for (int d0 = 0; d0 < 4; ++d0) { float* xp = xs_ + d0 * 64 * 16; \
      _Pragma("unroll") for (int q4 = 0; q4 < 4; ++q4) *(f32x4v*)(xp + 4 * q4) = (f32x4v){OV[d0][4 * q4], OV[d0][4 * q4 + 1], OV[d0][4 * q4 + 2], OV[d0][4 * q4 + 3]}; } } while (0)
#define XS_ADD(OV, BASE) do { const float* xs_ = (const float*)(lds + (BASE)) + ((g * 4) * 64 + lane) * 16; \
    _Pragma("unroll") for (int d0 = 0; d0 < 4; ++d0) { const float* xp = xs_ + d0 * 64 * 16; \
      _Pragma("unroll") for (int q4 = 0; q4 < 4; ++q4) { const f32x4v t = *(const f32x4v*)(xp + 4 * q4); OV[d0][4 * q4] += t[0]; OV[d0][4 * q4 + 1] += t[1]; OV[d0][4 * q4 + 2] += t[2]; OV[d0][4 * q4 + 3] += t[3]; } } } while (0)
  f32x16* olo = o; f32x16* ohi = o + 4;
  if (kh) { XS_WRITE(olo, 0); } else { XS_WRITE(ohi, 65536); }
  __syncthreads();
  if (kh) { XS_ADD(ohi, 65536);
#pragma unroll
    for (int d0 = 0; d0 < 4; ++d0) o[d0] = o[4 + d0]; }
  else { XS_ADD(olo, 0); }
#undef XS_WRITE
#undef XS_ADD
  float rli[16];
#pragma unroll
  for (int r = 0; r < 16; ++r) { const int row = crow(r, hi); const float* lp = L_lds + (g * 4) * 32 + row; rli[r] = __builtin_amdgcn_rcpf((lp[0] + lp[32]) + (lp[64] + lp[96])); }
  float* Ow = Ob + (long)(g * 32) * LDO + kh * 128;
  if (MODE == 0) {
#pragma unroll
    for (int r = 0; r < 16; ++r) { const int orow = crow(r, hi);
#pragma unroll
      for (int d0 = 0; d0 < 4; ++d0) Ow[(long)orow * LDO + d0 * 32 + r32] = o[d0][r] * rli[r]; }
    asm volatile("s_waitcnt vmcnt(0)" ::: "memory"); __syncthreads();
  } else {
    float ssq[16];
#pragma unroll
    for (int r = 0; r < 16; ++r) { const int orow = crow(r, hi); float s = 0.f;
#pragma unroll
      for (int d0 = 0; d0 < 4; ++d0) { const float v = Ow[(long)orow * LDO + d0 * 32 + r32] - lam * (o[d0][r] * rli[r]); o[d0][r] = v; s += v * v; }
      s += __shfl_xor(s, 1); s += __shfl_xor(s, 2); s += __shfl_xor(s, 4); s += __shfl_xor(s, 8); s += __shfl_xor(s, 16);
      ssq[r] = s; }
    __syncthreads();
    if (r32 == 0) {
#pragma unroll
      for (int r = 0; r < 16; ++r) L_lds[wid * 32 + crow(r, hi)] = ssq[r]; }
    __syncthreads();
    constexpr float ONE_M_LI = 1.f - 0.35550906759f;
    float sw[4];
#pragma unroll
    for (int d0 = 0; d0 < 4; ++d0) sw[d0] = subw[kh * 128 + d0 * 32 + r32] * ONE_M_LI;
    char* zt = lds + wid * 8704;
#pragma unroll
    for (int r = 0; r < 16; ++r) { const int orow = crow(r, hi);
      const float rstd = rsqrtf((L_lds[wid * 32 + orow] + L_lds[(wid ^ 1) * 32 + orow]) * (1.f / 256.f) + 1e-6f);
#pragma unroll
      for (int d0 = 0; d0 < 4; ++d0) { const float z = o[d0][r] * rstd * sw[d0];
        *(unsigned short*)(zt + orow * 272 + (d0 * 32 + r32) * 2) = (unsigned short)(cvtpk(z, z) & 0xffffu); } }
    asm volatile("s_waitcnt lgkmcnt(0)" ::: "memory");
    u32x4 gq[8];
#pragma unroll
    for (int i = 0; i < 8; ++i) { const int id = lane + 64 * i; gq[i] = *(const u32x4*)(Gw + (long)(g * 32 + (id >> 4)) * 2048 + kh * 128 + (id & 15) * 8); }
#pragma unroll
    for (int i = 0; i < 8; ++i) { const int id = lane + 64 * i, row = id >> 4, cc = id & 15;
      const u32x4 zz = *(const u32x4*)(zt + row * 272 + cc * 16);
      unsigned yo[4];
#pragma unroll
      for (int k = 0; k < 4; ++k) { const unsigned zw = zz[k], gw_ = gq[i][k];
        const float z0 = __builtin_bit_cast(float, zw << 16), z1 = __builtin_bit_cast(float, zw & 0xffff0000u);
        const float g0 = __builtin_bit_cast(float, gw_ << 16), g1 = __builtin_bit_cast(float, gw_ & 0xffff0000u);
        yo[k] = cvtpk(z0 * (g0 * __builtin_amdgcn_rcpf(1.f + __expf(-g0))), z1 * (g1 * __builtin_amdgcn_rcpf(1.f + __expf(-g1)))); }
      *(u32x4*)(A2w + (long)(g * 32 + row) * 2048 + kh * 128 + cc * 8) = (u32x4){yo[0], yo[1], yo[2], yo[3]}; }
    asm volatile("s_waitcnt vmcnt(0)" ::: "memory"); __syncthreads();
  }
}
template <int MODE>
__device__ __forceinline__ void attn_ks2_body(const bf16* __restrict__ Qb, const bf16* __restrict__ Kh, const bf16* __restrict__ Vh, float* Ob, unsigned short* A2w, const unsigned short* Gw, const float* subw,
                                             int seq, char* lds, float lam, float negMc) {
  using St = Stage<bf16>;
  int tid_ = threadIdx.x; asm volatile("" : "+v"(tid_));
  const int tid = tid_, wid = tid >> 6, lane = tid & 63, r32 = lane & 31, hi = lane >> 5, g = wid >> 1, kh = wid & 1;
  char* K_lds = lds; char* V_lds = lds + 49152; float* L_lds = (float*)(lds + 131072);
  constexpr float C = SCALE * 1.4426950408889634f;
  f32x16 o[8] = {}; bf16x8 qr[8]; float lsum = 0.f;
  const bf16* Qw = Qb + (long)(g * 32 + r32) * 128 + hi * 8;
#pragma unroll
  for (int d0 = 0; d0 < 8; ++d0) qr[d0] = St::ld8(Qw + d0 * 16);
  const int vb0 = (int)(uintptr_t)V_lds + v_rd_base(lane) + 2 * kh * 4096;
  const int krow = 32 * kh + r32;
  typedef __attribute__((address_space(3))) unsigned lds_u32;
  const int wu = __builtin_amdgcn_readfirstlane(wid);
  long gk[2], gv[2];
#pragma unroll
  for (int c = 0; c < 2; ++c) { const int q = wu + 8 * c;
    const int r = 4 * q + (lane >> 4), pch = lane & 15; gk[c] = (long)r * 128 + ((pch ^ (r & 7)) * 8);
    const int st = 2 * q + (lane >> 5), kk = (st >> 2) * 8 + ((lane >> 2) & 7), k = (kk & ~0xC) | ((kk & 4) << 1) | ((kk & 8) >> 1), cc = (st & 3) * 32 + (lane & 3) * 8;
    gv[c] = (long)k * 256 + cc; }
#define DMA16(gp, lp) __builtin_amdgcn_global_load_lds((const unsigned*)(gp), (lds_u32*)(lp), 16, 0, 0)
#define STAGE(k0, bb) do { const bf16* kt_ = Kh + (long)(k0) * 128; const bf16* vt_ = Vh + (long)(k0) * 256; \
    DMA16(kt_ + gk[0], K_lds + (bb) * 16384 + wu * 1024); DMA16(kt_ + gk[1], K_lds + (bb) * 16384 + (wu + 8) * 1024); \
    DMA16(vt_ + gv[0], V_lds + (bb) * 32768 + wu * 1024); DMA16(vt_ + gv[1], V_lds + (bb) * 32768 + (wu + 8) * 1024); \
    DMA16(vt_ + gv[0] + 128, V_lds + (bb) * 32768 + 16384 + wu * 1024); DMA16(vt_ + gv[1] + 128, V_lds + (bb) * 32768 + 16384 + (wu + 8) * 1024); } while (0)
#define RAWBAR() do { asm volatile("s_waitcnt lgkmcnt(0)" ::: "memory"); __builtin_amdgcn_s_barrier(); asm volatile("" ::: "memory"); } while (0)
  const int NT = seq / KVBLK;
  const bool early = wu < 4;
#define STAGE_K(k0, kb) do { const bf16* kt_ = Kh + (long)(k0) * 128; DMA16(kt_ + gk[0], K_lds + (kb) * 16384 + wu * 1024); DMA16(kt_ + gk[1], K_lds + (kb) * 16384 + (wu + 8) * 1024); } while (0)
#define STAGE_V(k0, vb_) do { const bf16* vt_ = Vh + (long)(k0) * 256; \
    DMA16(vt_ + gv[0], V_lds + (vb_) * 32768 + wu * 1024); DMA16(vt_ + gv[1], V_lds + (vb_) * 32768 + (wu + 8) * 1024); \
    DMA16(vt_ + gv[0] + 128, V_lds + (vb_) * 32768 + 16384 + wu * 1024); DMA16(vt_ + gv[1] + 128, V_lds + (vb_) * 32768 + 16384 + (wu + 8) * 1024); } while (0)
#define SCORE(kb, OWN0, OWN1) do { const char* Kb = K_lds + (kb) * 16384; f32x16 pe = {}, po = {}; \
    _Pragma("unroll") for (int d0 = 0; d0 < 8; d0 += 2) { \
      const bf16x8 k0 = *reinterpret_cast<const bf16x8*>(Kb + KSWZ(krow, (d0 * 16 + hi * 8) * 2)); \
      const bf16x8 k1 = *reinterpret_cast<const bf16x8*>(Kb + KSWZ(krow, ((d0 + 1) * 16 + hi * 8) * 2)); \
      pe = __builtin_amdgcn_mfma_f32_32x32x16_bf16(k0, qr[d0], pe, 0, 0, 0); \
      po = __builtin_amdgcn_mfma_f32_32x32x16_bf16(k1, qr[d0 + 1], po, 0, 0, 0); } \
    f32x16 p; _Pragma("unroll") for (int r = 0; r < 16; ++r) p[r] = __builtin_amdgcn_exp2f(fmaf(pe[r] + po[r], C, negMc)); \
    float ps = 0.f; _Pragma("unroll") for (int r = 0; r < 16; ++r) ps += p[r]; lsum += ps; \
    OWN0 = pk8(p, 0); OWN1 = pk8(p, 8); } while (0)
#define PVALL(vb_, OWN0, OWN1) do { const int vo = vb0 + (vb_) * 32768; \
    pv_pair<0, 1>(o[0], o[1], vo, OWN0, OWN1); pv_pair<2, 3>(o[2], o[3], vo, OWN0, OWN1); \
    pv_pair<0, 1>(o[4], o[5], vo + 16384, OWN0, OWN1); pv_pair<2, 3>(o[6], o[7], vo + 16384, OWN0, OWN1); } while (0)
  STAGE_K(0, 0); STAGE_K(KVBLK, 1); STAGE_V(0, 0); asm volatile("s_waitcnt vmcnt(0)" ::: "memory"); RAWBAR();
  bf16x8 own0, own1;
  if (!early) { SCORE(0, own0, own1); }
  int kb0 = 0, kb1 = 1, kb2 = 2;
  for (int j = 0; j < NT; ++j) {
    const int vbuf = j & 1;
    if (j + 2 < NT) { STAGE_K((j + 2) * KVBLK, kb2); }
    if (j + 1 < NT) { STAGE_V((j + 1) * KVBLK, vbuf ^ 1); }
    if (early) { SCORE(kb0, own0, own1); }
    const bf16x8 c0 = own0, c1 = own1;
    SBAR();
    PVALL(vbuf, c0, c1);
    SBAR();
    if (!early) { if (j + 1 < NT) { SCORE(kb1, own0, own1); } }
    asm volatile("s_waitcnt vmcnt(0)" ::: "memory");
    RAWBAR();
    { const int t_ = kb0; kb0 = kb1; kb1 = kb2; kb2 = t_; }
  }
#undef STAGE_K
#undef STAGE_V
#undef SCORE
#undef PVALL
#undef DMA16
#undef STAGE
#undef RAWBAR
  L_lds[(wid * 2 + hi) * 32 + r32] = lsum;
#define XS_WRITE(OV, BASE) do { float* xs_ = (float*)(lds + (BASE)) + ((g * 4) * 64 + lane) * 16; \
    _Pragma("unroll") for (int d0 = 0; d0 < 4; ++d0) { float* xp = xs_ + d0 * 64 * 16; \
      _Pragma("unroll") for (int q4 = 0; q4 < 4; ++q4) *(f32x4v*)(xp + 4 * q4) = (f32x4v){OV[d0][4 * q4], OV[d0][4 * q4 + 1], OV[d0][4 * q4 + 2], OV[d0][4 * q4 + 3]}; } } while (0)
#define XS_ADD(OV, BASE) do { const float* xs_ = (const float*)(lds + (BASE)) + ((g * 4) * 64 + lane) * 16; \
    _Pragma("unroll") for (int d0 = 0; d0 < 4; ++d0) { const float* xp = xs_ + d0 * 64 * 16; \
      _Pragma("unroll") for (int q4 = 0; q4 < 4; ++q4) { const f32x4v t = *(const f32x4v*)(xp + 4 * q4); OV[d0][4 * q4] += t[0]; OV[d0][4 * q4 + 1] += t[1]; OV[d0][4 * q4 + 2] += t[2]; OV[d0][4 * q4 + 3] += t[3]; } } } while (0)
  f32x16* olo = o; f32x16* ohi = o + 4;
  if (kh) { XS_WRITE(olo, 0); } else { XS_WRITE(ohi, 65536); }
  __syncthreads();
  if (kh) { XS_ADD(ohi, 65536);
#pragma unroll
    for (int d0 = 0; d0 < 4; ++d0) o[d0] = o[4 + d0]; }
  else { XS_ADD(olo, 0); }
#undef XS_WRITE
#undef XS_ADD
  float rli[16];
#pragma unroll
  for (int r = 0; r < 16; ++r) { const int row = crow(r, hi); const float* lp = L_lds + (g * 4) * 32 + row; rli[r] = __builtin_amdgcn_rcpf((lp[0] + lp[32]) + (lp[64] + lp[96])); }
  float* Ow = Ob + (long)(g * 32) * LDO + kh * 128;
  if (MODE == 0) {
#pragma unroll
    for (int r = 0; r < 16; ++r) { const int orow = crow(r, hi);
#pragma unroll
      for (int d0 = 0; d0 < 4; ++d0) Ow[(long)orow * LDO + d0 * 32 + r32] = o[d0][r] * rli[r]; }
    asm volatile("s_waitcnt vmcnt(0)" ::: "memory"); __syncthreads();
  } else {
    float ssq[16];
#pragma unroll
    for (int r = 0; r < 16; ++r) { const int orow = crow(r, hi); float s = 0.f;
#pragma unroll
      for (int d0 = 0; d0 < 4; ++d0) { const float v = Ow[(long)orow * LDO + d0 * 32 + r32] - lam * (o[d0][r] * rli[r]); o[d0][r] = v; s += v * v; }
      s += __shfl_xor(s, 1); s += __shfl_xor(s, 2); s += __shfl_xor(s, 4); s += __shfl_xor(s, 8); s += __shfl_xor(s, 16);
      ssq[r] = s; }
    __syncthreads();
    if (r32 == 0) {
#pragma unroll
      for (int r = 0; r < 16; ++r) L_lds[wid * 32 + crow(r, hi)] = ssq[r]; }
    __syncthreads();
    constexpr float ONE_M_LI = 1.f - 0.35550906759f;
    float sw[4];
#pragma unroll
    for (int d0 = 0; d0 < 4; ++d0) sw[d0] = subw[kh * 128 + d0 * 32 + r32] * ONE_M_LI;
    char* zt = lds + wid * 8704;
#pragma unroll
    for (int r = 0; r < 16; ++r) { const int orow = crow(r, hi);
      const float rstd = rsqrtf((L_lds[wid * 32 + orow] + L_lds[(wid ^ 1) * 32 + orow]) * (1.f / 256.f) + 1e-6f);
#pragma unroll
      for (int d0 = 0; d0 < 4; ++d0) { const float z = o[d0][r] * rstd * sw[d0];
        *(unsigned short*)(zt + orow * 272 + (d0 * 32 + r32) * 2) = (unsigned short)(cvtpk(z, z) & 0xffffu); } }
    asm volatile("s_waitcnt lgkmcnt(0)" ::: "memory");
    u32x4 gq[8];
#pragma unroll
    for (int i = 0; i < 8; ++i) { const int id = lane + 64 * i; gq[i] = *(const u32x4*)(Gw + (long)(g * 32 + (id >> 4)) * 2048 + kh * 128 + (id & 15) * 8); }
#pragma unroll
    for (int i = 0; i < 8; ++i) { const int id = lane + 64 * i, row = id >> 4, cc = id & 15;
      const u32x4 zz = *(const u32x4*)(zt + row * 272 + cc * 16);
      unsigned yo[4];
#pragma unroll
      for (int k = 0; k < 4; ++k) { const unsigned zw = zz[k], gw_ = gq[i][k];
        const float z0 = __builtin_bit_cast(float, zw << 16), z1 = __builtin_bit_cast(float, zw & 0xffff0000u);
        const float g0 = __builtin_bit_cast(float, gw_ << 16), g1 = __builtin_bit_cast(float, gw_ & 0xffff0000u);
        yo[k] = cvtpk(z0 * (g0 / (1.f + __expf(-g0))), z1 * (g1 / (1.f + __expf(-g1)))); }
      *(u32x4*)(A2w + (long)(g * 32 + row) * 2048 + kh * 128 + cc * 8) = (u32x4){yo[0], yo[1], yo[2], yo[3]}; }
    asm volatile("s_waitcnt vmcnt(0)" ::: "memory"); __syncthreads();
  }
}
}
#define GAS __attribute__((address_space(1)))
#define LAS __attribute__((address_space(3)))
typedef unsigned short bf16;
typedef unsigned v4u __attribute__((ext_vector_type(4)));
typedef unsigned v2u __attribute__((ext_vector_type(2)));
typedef float f32x4 __attribute__((ext_vector_type(4)));
#define LDS_WAIT() asm volatile("s_waitcnt lgkmcnt(0)" ::: "memory")
__device__ __forceinline__ unsigned f2bf(float f) { unsigned u = __builtin_bit_cast(unsigned, f); return (u + 0x7fffu + ((u >> 16) & 1u)) >> 16; }
typedef __bf16 bf16x2_t __attribute__((ext_vector_type(2)));
typedef float f32x2_t __attribute__((ext_vector_type(2)));
__device__ __forceinline__ unsigned pk2(float lo, float hi) { const f32x2_t v = {lo, hi}; const bf16x2_t b = __builtin_convertvector(v, bf16x2_t); return __builtin_bit_cast(unsigned, b); }
__device__ __forceinline__ float bf2f(unsigned short h) { return __builtin_bit_cast(float, (unsigned)h << 16); }
__device__ __forceinline__ float bflo(unsigned w) { return __builtin_bit_cast(float, w << 16); }
__device__ __forceinline__ float bfhi(unsigned w) { return __builtin_bit_cast(float, w & 0xffff0000u); }
__device__ __forceinline__ float wave_sum(float v) {
#pragma unroll
    for (int o = 1; o < 64; o <<= 1) v += __shfl_xor(v, o);
    return v;
}
__device__ __forceinline__ float siluf(float x) { return x * __builtin_amdgcn_rcpf(1.f + __expf(-x)); }

constexpr int DM = 2048, NB = 2, SEQ = 16384, CL = 256, TB = SEQ + CL, MT = NB * TB;
constexpr int N0 = 6144, N0P = 6400, N1 = 8192;
constexpr float EPS = 1e-6f;
constexpr float LAMBDA_INIT = 0.35550906759f;
constexpr size_t MiB = 1u << 20;
constexpr size_t WS_MODS = 0;
constexpr size_t MODS_BYTES = 2 * 3 * 6144 * 4;
constexpr size_t WS_BAR = 256 * 1024;
constexpr size_t CTL_ZERO_BYTES = WS_BAR + 3456 * 4;
constexpr size_t WS_ROPE = 512 * 1024;
constexpr size_t WS_R = 1 * MiB;
constexpr size_t WS_CTX1 = 6 * MiB;
constexpr size_t WS_WT0 = 10 * MiB, WS_WT1 = 35 * MiB, WS_WT2 = 43 * MiB, WS_WT3 = 75 * MiB;
constexpr size_t WS_H = 83 * MiB;
constexpr size_t WS_P = 213 * MiB;
constexpr size_t WS_OF = WS_H;
constexpr size_t WS_KDT = 603 * MiB;
constexpr size_t WS_PC = 733 * MiB;
constexpr size_t WS_VT = 750 * MiB;
constexpr size_t WS_OB = 880 * MiB;
constexpr size_t WS_ET = 1010 * MiB;
constexpr size_t WS_OATT = 733 * MiB;
constexpr size_t WS_END = 1015 * MiB;
constexpr int LDS_MISC = 131072, LDS_XBAR = 147456, LDS_BYTES = 147456 + 256;

struct Args { const float* in[19]; float* out; unsigned char* ws; int ph_lo, ph_hi; };
enum { I_X = 0, I_C, I_CTX, I_CCTX, I_NORMW, I_ADAW, I_ADAB, I_GWIN, I_GA1, I_GA2, I_GB, I_GGN, I_GWOUT, I_DWIN, I_DQN, I_DKN, I_DLAM, I_DSUB, I_DWOUT };

__device__ __forceinline__ void p0_transpose_item(const float* W, int K, int N, bf16* WT, int row_off, LAS float* scr, int item, int lane) {
    const int nblk = N / 32, kb = item / nblk, nb = item % nblk, k0 = 64 * kb, n0 = 32 * nb;
#pragma unroll 16
    for (int i = 0; i < 32; ++i) { const int kk = 2 * i + (lane >> 5); scr[kk * 33 + (lane & 31)] = W[(size_t)(k0 + kk) * N + n0 + (lane & 31)]; }
    LDS_WAIT(); asm volatile("" ::: "memory");
    const int c = lane & 7;
#pragma unroll
    for (int j = 0; j < 4; ++j) { const int n = (lane >> 3) + 8 * j; const LAS float* s = scr + (8 * c) * 33 + n;
        v4u o; o.x = pk2(s[0 * 33], s[1 * 33]); o.y = pk2(s[2 * 33], s[3 * 33]); o.z = pk2(s[4 * 33], s[5 * 33]); o.w = pk2(s[6 * 33], s[7 * 33]);
        *(GAS v4u*)(WT + (size_t)(row_off + n0 + n) * K + k0 + 8 * c) = o; }
    LDS_WAIT(); asm volatile("" ::: "memory");
}

__device__ __forceinline__ void ph_prologue(const Args& a, LAS unsigned char* lds) {
    const int tid = threadIdx.x, lane = tid & 63, wave = tid >> 6, G = gridDim.x;
    float* mods = (float*)(a.ws + WS_MODS);
    LAS float* sil = (LAS float*)(lds + LDS_MISC);
    for (int it = blockIdx.x; it < 768; it += G) {
        const int l = it / 384, cb = (it % 384) / 16, ks = it % 16;
        if (tid < 384) { const int cond = tid >> 7, kk = tid & 127, k = ks * 128 + kk;
            const float cv = (cond < 2) ? a.in[I_C][cond * 2048 + k] : a.in[I_CCTX][k]; sil[tid] = siluf(cv); }
        __syncthreads();
        const int col = cb * 256 + (tid & 255), kh = tid >> 8;
        const float* w = a.in[I_ADAW] + ((size_t)l * 2048 + ks * 128 + kh * 64) * 6144 + col;
        float s0 = 0.f, s1 = 0.f, s2 = 0.f;
#pragma unroll 16
        for (int kk = 0; kk < 64; ++kk) { const float wv = w[(size_t)kk * 6144]; const int q = kh * 64 + kk; s0 += sil[q] * wv; s1 += sil[128 + q] * wv; s2 += sil[256 + q] * wv; }
        if (ks == 0 && kh == 0) { const float bv = a.in[I_ADAB][l * 6144 + col]; s0 += bv; s1 += bv; s2 += bv; }
        atomicAdd(&mods[(l * 3 + 0) * 6144 + col], s0); atomicAdd(&mods[(l * 3 + 1) * 6144 + col], s1); atomicAdd(&mods[(l * 3 + 2) * 6144 + col], s2);
        __syncthreads();
    }
    bf16* WT0 = (bf16*)(a.ws + WS_WT0); bf16* WT1 = (bf16*)(a.ws + WS_WT1); bf16* WT2 = (bf16*)(a.ws + WS_WT2); bf16* WT3 = (bf16*)(a.ws + WS_WT3);
    LAS float* scr = (LAS float*)(lds + wave * 16384);
    const int gw = blockIdx.x * 8 + wave, NGW = G * 8;
    constexpr int IT0 = 32 * (N0 / 32), IT1 = 32 * 64, IT2 = 32 * (N1 / 32), IT3 = 32 * 64;
    for (int it = gw; it < IT0 + IT1 + IT2 + IT3; it += NGW) {
        int r = it;
        if (r < IT0) { p0_transpose_item(a.in[I_GWIN], 2048, N0, WT0, 0, scr, r, lane); continue; } r -= IT0;
        if (r < IT1) { p0_transpose_item(a.in[I_GWOUT], 2048, 2048, WT1, 0, scr, r, lane); continue; } r -= IT1;
        if (r < IT2) { p0_transpose_item(a.in[I_DWIN], 2048, N1, WT2, 0, scr, r, lane); continue; } r -= IT2;
        p0_transpose_item(a.in[I_DWOUT], 2048, 2048, WT3, 0, scr, r, lane);
    }
    const int gt = blockIdx.x * 512 + tid, NGT = G * 512;
    for (int idx = gt; idx < 32 * 2048; idx += NGT) { const int row = idx >> 11, k = idx & 2047, dir = row >> 4, r = row & 15;
        WT0[(size_t)(N0 + row) * 2048 + k] = (bf16)f2bf(a.in[I_GA1][((size_t)dir * 2048 + k) * 16 + r]); }
    for (int idx = gt; idx < 224 * 2048 / 8; idx += NGT) *(v4u*)(WT0 + (size_t)(N0 + 32) * 2048 + (size_t)idx * 8) = (v4u){0u, 0u, 0u, 0u};
    float* ropec = (float*)(a.ws + WS_ROPE); float* ropes = ropec + 8192;
    for (int idx = gt; idx < 8192; idx += NGT) { const int pos = idx >> 5, j = idx & 31;
        const float invf = (float)exp2(-(double)j * (1.0 / 32.0) * 13.287712379549449);
        const float ang = (float)pos * invf;
        double rev = (double)ang * 0.15915494309189535; rev -= floor(rev);
        const float rf = (float)rev;
        ropec[idx] = __builtin_amdgcn_cosf(rf); ropes[idx] = __builtin_amdgcn_sinf(rf); }
}

__device__ __forceinline__ void ph_norm(const Args& a, int layer, const float* xL, const float* xC) {
    const int lane = threadIdx.x & 63, wave = threadIdx.x >> 6; const int gw = blockIdx.x * 8 + wave, NGW = gridDim.x * 8;
    const float* mods = (const float*)(a.ws + WS_MODS) + (size_t)layer * 3 * 6144; const float* nw = a.in[I_NORMW] + layer * 2048;
    bf16* H = (bf16*)(a.ws + WS_H);
    for (int row = gw; row < MT; row += 2 * NGW) {
        const int row2 = row + NGW; const bool has2 = row2 < MT;
        const int b = row / TB, t = row % TB, b2 = has2 ? row2 / TB : b, t2 = has2 ? row2 % TB : t;
        const float* src = (t < SEQ) ? xL + ((size_t)b * SEQ + t) * 2048 : xC + ((size_t)b * CL + (t - SEQ)) * 2048;
        const float* src2 = (t2 < SEQ) ? xL + ((size_t)b2 * SEQ + t2) * 2048 : xC + ((size_t)b2 * CL + (t2 - SEQ)) * 2048;
        const float* md = mods + ((t < SEQ) ? b : 2) * 6144; const float* md2 = mods + ((t2 < SEQ) ? b2 : 2) * 6144;
        f32x4 v[8], u[8]; float ss = 0.f, ss2 = 0.f;
#pragma unroll
        for (int j = 0; j < 8; ++j) { v[j] = *(const f32x4*)(src + 256 * j + 4 * lane); u[j] = *(const f32x4*)(src2 + 256 * j + 4 * lane); }
#pragma unroll
        for (int j = 0; j < 8; ++j) { ss += (v[j].x * v[j].x + v[j].y * v[j].y) + (v[j].z * v[j].z + v[j].w * v[j].w); ss2 += (u[j].x * u[j].x + u[j].y * u[j].y) + (u[j].z * u[j].z + u[j].w * u[j].w); }
        const float rstd = rsqrtf(wave_sum(ss) * (1.f / 2048.f) + EPS), rstd2 = rsqrtf(wave_sum(ss2) * (1.f / 2048.f) + EPS);
#pragma unroll
        for (int j = 0; j < 8; ++j) { const int c = 256 * j + 4 * lane;
            const f32x4 w4 = *(const f32x4*)(nw + c);
            { const f32x4 sh = *(const f32x4*)(md + c), sc = *(const f32x4*)(md + 2048 + c); const f32x4 y = (v[j] * rstd) * w4 * (sc + 1.f) + sh;
              *(v2u*)(H + (size_t)row * 2048 + c) = (v2u){pk2(y.x, y.y), pk2(y.z, y.w)}; }
            if (has2) { const f32x4 sh = *(const f32x4*)(md2 + c), sc = *(const f32x4*)(md2 + 2048 + c); const f32x4 y = (u[j] * rstd2) * w4 * (sc + 1.f) + sh;
              *(v2u*)(H + (size_t)row2 * 2048 + c) = (v2u){pk2(y.x, y.y), pk2(y.z, y.w)}; } }
    }
}

__device__ __forceinline__ int gla_row(int b, int dir, int n) {
    int t; if (n < CL) t = SEQ + (dir ? (CL - 1 - n) : n); else { const int m = n - CL; t = dir ? (SEQ - 1 - m) : m; }
    return b * TB + t;
}
__device__ __forceinline__ void ph_gla_naive(const Args& a, LAS unsigned char* lds) {
    const int tid = threadIdx.x;
    const bf16* P = (const bf16*)(a.ws + WS_P); const float* R = (const float*)(a.ws + WS_R);
    LAS float* bufE = (LAS float*)lds;
    LAS float* bufK = bufE + 2 * 16 * 256;
    LAS float* bufQ = bufK + 2 * 16 * 256;
    LAS float* bufV = bufQ + 2 * 16 * 256;
    for (int item = blockIdx.x; item < 256; item += gridDim.x) {
        const int chain = item >> 4, eb = item & 15, b = chain >> 3, h = (chain >> 1) & 3, dir = chain & 1;
        bf16* O = (bf16*)(a.ws + (dir ? WS_OB : WS_OF));
        const int e = tid >> 4, ds = tid & 15, dp = tid & 255, tp = tid >> 8;
        float a2c[16];
#pragma unroll
        for (int r = 0; r < 16; ++r) a2c[r] = a.in[I_GA2][(size_t)(dir * 16 + r) * 1024 + h * 256 + dp];
        const float gbv = a.in[I_GB][dir * 1024 + h * 256 + dp];
        float s[16];
#pragma unroll
        for (int i = 0; i < 16; ++i) s[i] = 0.f;
#define GLA_PREP(bt, buf) do { \
        _Pragma("unroll") for (int j = 0; j < 8; ++j) { const int tk = tp + 2 * j; const int row = gla_row(b, dir, (bt) * 16 + tk); \
            const float* rr = R + (size_t)row * 32 + dir * 16; float g = gbv; \
            _Pragma("unroll") for (int r = 0; r < 16; ++r) g += rr[r] * a2c[r]; \
            const float ls = fminf(g, 0.f) - __logf(1.f + __expf(-fabsf(g))); \
            bufE[((buf) * 16 + tk) * 256 + dp] = __expf(ls * (1.f / 16.f)); \
            bufQ[((buf) * 16 + tk) * 256 + dp] = bf2f(P[(size_t)row * N0 + h * 256 + dp]); \
            bufK[((buf) * 16 + tk) * 256 + dp] = bf2f(P[(size_t)row * N0 + 1024 + h * 256 + dp]); } \
        { const int tk = tid >> 5, ee = tid & 31; const int row = gla_row(b, dir, (bt) * 16 + tk); \
            bufV[((buf) * 16 + tk) * 32 + ee] = bf2f(P[(size_t)row * N0 + 2048 + h * 512 + eb * 32 + ee]); } } while (0)
        __syncthreads();
        GLA_PREP(0, 0);
        __syncthreads();
        constexpr int NBT = TB / 16;
        for (int bt = 0; bt < NBT; ++bt) {
            const int cur = bt & 1;
            if (bt + 1 < NBT) GLA_PREP(bt + 1, cur ^ 1);
            for (int tk = 0; tk < 16; ++tk) {
                const float v = bufV[(cur * 16 + tk) * 32 + e]; float acc = 0.f;
#pragma unroll
                for (int i = 0; i < 4; ++i) {
                    const f32x4 e4 = *(const LAS f32x4*)(bufE + (cur * 16 + tk) * 256 + i * 64 + ds * 4);
                    const f32x4 k4 = *(const LAS f32x4*)(bufK + (cur * 16 + tk) * 256 + i * 64 + ds * 4);
                    const f32x4 q4 = *(const LAS f32x4*)(bufQ + (cur * 16 + tk) * 256 + i * 64 + ds * 4);
                    s[4 * i + 0] = e4.x * s[4 * i + 0] + k4.x * v; acc += q4.x * s[4 * i + 0];
                    s[4 * i + 1] = e4.y * s[4 * i + 1] + k4.y * v; acc += q4.y * s[4 * i + 1];
                    s[4 * i + 2] = e4.z * s[4 * i + 2] + k4.z * v; acc += q4.z * s[4 * i + 2];
                    s[4 * i + 3] = e4.w * s[4 * i + 3] + k4.w * v; acc += q4.w * s[4 * i + 3];
                }
                acc += __shfl_xor(acc, 1); acc += __shfl_xor(acc, 2); acc += __shfl_xor(acc, 4); acc += __shfl_xor(acc, 8);
                if (ds == 0) { const int row = gla_row(b, dir, bt * 16 + tk); O[(size_t)row * 2048 + h * 512 + eb * 32 + e] = (bf16)f2bf(acc); }
            }
            __syncthreads();
        }
#undef GLA_PREP
    }
}


typedef short bf16x8_t __attribute__((ext_vector_type(8)));
typedef float f32x16_t __attribute__((ext_vector_type(16)));
__device__ __forceinline__ float logsig16(float g) { return (fminf(g, 0.f) - __logf(1.f + __expf(-fabsf(g)))) * (1.f / 16.f); }
__device__ __forceinline__ void ph_gla_pre(const Args& a, LAS unsigned char* lds) {
    const int tid = threadIdx.x, lane = tid & 63, wave = tid >> 6;
    bf16* P = (bf16*)(a.ws + WS_P); const float* R = (const float*)(a.ws + WS_R);
    bf16* KDT = (bf16*)(a.ws + WS_KDT); bf16* PC = (bf16*)(a.ws + WS_PC); bf16* VT = (bf16*)(a.ws + WS_VT); float* ET = (float*)(a.ws + WS_ET);
    LAS float* Rt = (LAS float*)(lds + 131072); LAS float* PcT = (LAS float*)(lds + 131072);
    for (int item = blockIdx.x; item < 2080; item += gridDim.x) {
        const int bh = item / 260, c = item % 260, b = bh >> 2, h = bh & 3;
        const size_t row0 = (size_t)b * TB + (size_t)c * 64;
#pragma unroll
        for (int j = 0; j < 8; ++j) { const int piece = tid + 512 * j, r = piece >> 6, cc = piece & 63;
            *(LAS v4u*)(lds + r * 1040 + cc * 16) = *(const v4u*)(P + (row0 + r) * N0 + 2048 + h * 512 + cc * 8); }
        __syncthreads();
        { bf16* vrow = VT + ((size_t)item * 512 + tid) * 64;
#pragma unroll
          for (int g8 = 0; g8 < 8; ++g8) { unsigned w[4];
#pragma unroll
            for (int q = 0; q < 4; ++q) { const unsigned lo = *(const LAS unsigned short*)(lds + (g8 * 8 + 2 * q) * 1040 + tid * 2), hi = *(const LAS unsigned short*)(lds + (g8 * 8 + 2 * q + 1) * 1040 + tid * 2); w[q] = lo | (hi << 16); }
            *(v4u*)(vrow + g8 * 8) = (v4u){w[0], w[1], w[2], w[3]}; } }
        { const int r = tid >> 3, q4 = tid & 7; *(LAS f32x4*)(lds + 131072 + tid * 16) = *(const f32x4*)(R + (row0 + r) * 32 + q4 * 4); }
        __syncthreads();
        {
            const int d = tid & 255, dir = tid >> 8;
            float a2c[16];
#pragma unroll
            for (int r = 0; r < 16; ++r) a2c[r] = a.in[I_GA2][(size_t)(dir * 16 + r) * 1024 + h * 256 + d];
            const float gbv = a.in[I_GB][dir * 1024 + h * 256 + d];
            float bc = 0.f;
            LAS unsigned char* qe_t = lds + dir * 32768; LAS unsigned char* ki_t = lds + 65536 + dir * 32768;
            bf16* kdrow = KDT + ((((size_t)(dir * 2 + b) * 4 + h) * 260 + c) * 256 + d) * 64;
            unsigned short qn[8], kn[8];
#pragma unroll
            for (int jj = 0; jj < 8; ++jj) { const int i = dir ? 63 - jj : jj; qn[jj] = P[(row0 + i) * N0 + h * 256 + d]; kn[jj] = P[(row0 + i) * N0 + 1024 + h * 256 + d]; }
            for (int ib = 0; ib < 8; ++ib) {
                float kdv[8]; unsigned short qc[8], kc[8];
#pragma unroll
                for (int jj = 0; jj < 8; ++jj) { qc[jj] = qn[jj]; kc[jj] = kn[jj]; }
                if (ib < 7) {
#pragma unroll
                    for (int jj = 0; jj < 8; ++jj) { const int ii = (ib + 1) * 8 + jj, i = dir ? 63 - ii : ii; qn[jj] = P[(row0 + i) * N0 + h * 256 + d]; kn[jj] = P[(row0 + i) * N0 + 1024 + h * 256 + d]; } }
#pragma unroll
                for (int jj = 0; jj < 8; ++jj) { const int ii = ib * 8 + jj, i = dir ? 63 - ii : ii;
                    const LAS f32x4* rp = (const LAS f32x4*)(Rt + i * 32 + dir * 16);
                    const f32x4 r0 = rp[0], r1 = rp[1], r2 = rp[2], r3 = rp[3];
                    float g = gbv;
                    g += r0.x * a2c[0] + r0.y * a2c[1] + r0.z * a2c[2] + r0.w * a2c[3];
                    g += r1.x * a2c[4] + r1.y * a2c[5] + r1.z * a2c[6] + r1.w * a2c[7];
                    g += r2.x * a2c[8] + r2.y * a2c[9] + r2.z * a2c[10] + r2.w * a2c[11];
                    g += r3.x * a2c[12] + r3.y * a2c[13] + r3.z * a2c[14] + r3.w * a2c[15];
                    bc += logsig16(g);
                    const float q = bf2f(qc[jj]), k = bf2f(kc[jj]);
                    const float ex = __expf(bc), em = __expf(fminf(-bc, 80.f));
                    const int so = i * 512 + (((d >> 3) ^ (i & 15)) << 4) + (d & 7) * 2;
                    *(LAS unsigned short*)(qe_t + so) = (unsigned short)f2bf(q * ex);
                    *(LAS unsigned short*)(ki_t + so) = (unsigned short)f2bf(k * em);
                    kdv[jj] = k * em; }
                v4u w;
                if (dir == 0) w = (v4u){pk2(kdv[0], kdv[1]), pk2(kdv[2], kdv[3]), pk2(kdv[4], kdv[5]), pk2(kdv[6], kdv[7])};
                else          w = (v4u){pk2(kdv[7], kdv[6]), pk2(kdv[5], kdv[4]), pk2(kdv[3], kdv[2]), pk2(kdv[1], kdv[0])};
                const int tok0 = dir ? 56 - ib * 8 : ib * 8;
                *(v4u*)(kdrow + tok0) = w;
            }
            ET[(((size_t)(dir * 2 + b) * 4 + h) * 260 + c) * 256 + d] = __expf(bc);
        }
        __syncthreads();
#pragma unroll
        for (int j = 0; j < 8; ++j) { const int ch = tid + 512 * j, dirq = ch >> 11, rem = ch & 2047, i = rem >> 5, oc = rem & 31, pg = oc >> 2, kgq = oc & 3;
            const int c1 = 4 * pg + (kgq >> 1), half = kgq & 1;
            const v2u lo = *(const LAS v2u*)(lds + dirq * 32768 + i * 512 + ((c1 ^ (i & 15)) << 4) + half * 8);
            const v2u hi = *(const LAS v2u*)(lds + dirq * 32768 + i * 512 + (((c1 + 2) ^ (i & 15)) << 4) + half * 8);
            *(v4u*)(P + (row0 + i) * N0 + dirq * 1024 + h * 256 + oc * 8) = (v4u){lo.x, lo.y, hi.x, hi.y}; }
        const int dirw = wave >> 2, ib2 = (wave >> 1) & 1, jb2 = wave & 1, r32 = lane & 31, hi2 = lane >> 5;
        const bool skip = (dirw == 0) ? (ib2 == 0 && jb2 == 1) : (ib2 == 1 && jb2 == 0);
        f32x16_t accP = {};
        if (!skip) {
            const int jr = 32 * jb2 + r32, ir = 32 * ib2 + r32;
#pragma unroll
            for (int ks = 0; ks < 16; ++ks) { const int chk = ks * 2 + hi2;
                const bf16x8_t af = *(const LAS bf16x8_t*)(lds + 65536 + dirw * 32768 + jr * 512 + ((chk ^ (jr & 15)) << 4));
                const bf16x8_t bf = *(const LAS bf16x8_t*)(lds + dirw * 32768 + ir * 512 + ((chk ^ (ir & 15)) << 4));
                accP = __builtin_amdgcn_mfma_f32_32x32x16_bf16(af, bf, accP, 0, 0, 0); }
        }
        {   const int iq = 32 * ib2 + r32;
#pragma unroll
            for (int r = 0; r < 16; ++r) { const int jq = 32 * jb2 + (r & 3) + 8 * (r >> 2) + 4 * hi2; const bool keep = (dirw == 0) ? (jq <= iq) : (jq >= iq); accP[r] = (keep && !skip) ? accP[r] : 0.f; }
            __syncthreads();
            if (dirw == 0) {
#pragma unroll
                for (int g4 = 0; g4 < 4; ++g4) *(LAS f32x4*)(PcT + iq * 64 + 32 * jb2 + 8 * g4 + 4 * hi2) = (f32x4){accP[4 * g4], accP[4 * g4 + 1], accP[4 * g4 + 2], accP[4 * g4 + 3]};
            }
            __syncthreads();
            if (dirw == 1 && !skip) {
#pragma unroll
                for (int g4 = 0; g4 < 4; ++g4) { LAS f32x4* pp = (LAS f32x4*)(PcT + iq * 64 + 32 * jb2 + 8 * g4 + 4 * hi2); *pp = *pp + (f32x4){accP[4 * g4], accP[4 * g4 + 1], accP[4 * g4 + 2], accP[4 * g4 + 3]}; }
            }
            __syncthreads();
        }
        { const int i = tid >> 3, j0 = (tid & 7) * 8; const f32x4 x0 = *(const LAS f32x4*)(PcT + i * 64 + j0), x1 = *(const LAS f32x4*)(PcT + i * 64 + j0 + 4);
          *(v4u*)(PC + ((size_t)item * 64 + i) * 64 + j0) = (v4u){pk2(x0.x, x0.y), pk2(x0.z, x0.w), pk2(x1.x, x1.y), pk2(x1.z, x1.w)}; }
        __syncthreads();
    }
}

__device__ __forceinline__ void ph_gla_scan(const Args& a, LAS unsigned char* lds) {
    const int tid = threadIdx.x, lane = tid & 63, wave = __builtin_amdgcn_readfirstlane(tid >> 6), l16 = lane & 15, kg = lane >> 4;
    const bf16* P = (const bf16*)(a.ws + WS_P);
    const bf16* KDT = (const bf16*)(a.ws + WS_KDT); const bf16* PC = (const bf16*)(a.ws + WS_PC); const bf16* VT = (const bf16*)(a.ws + WS_VT); const float* ET = (const float*)(a.ws + WS_ET);
    constexpr int QS = 528, RS = 144, L_K = 33792, L_V = 70656, L_P = 79872, L_E = 89088;
    for (int item = blockIdx.x; item < 128; item += gridDim.x) {
        const int chain = item >> 3, dvb = item & 7, b = chain >> 3, h = (chain >> 1) & 3, dir = chain & 1, bh = b * 4 + h;
#define GS_CHUNK(n) (dir ? 259 - (n) : ((n) < 4 ? 256 + (n) : (n) - 4))
        if (wave >= 4) {
            const int ht = tid - 256;
            v4u Qa[12], Qb[12], Ka[9], Kb[9];
#define GS_LOADQ(S, n) do { const int c_ = GS_CHUNK(n); const size_t row0_ = (size_t)b * TB + (size_t)c_ * 64; \
            _Pragma("unroll") for (int j = 0; j < 8; ++j) { const int piece = ht + 256 * j; S[j] = *(const v4u*)(P + (row0_ + (piece >> 5)) * N0 + dir * 1024 + h * 256 + (piece & 31) * 8); } \
            const bf16* vb_ = VT + (((size_t)bh * 260 + c_) * 512 + dvb * 64) * 64; \
            _Pragma("unroll") for (int j = 0; j < 2; ++j) S[8 + j] = *(const v4u*)(vb_ + (size_t)(ht + 256 * j) * 8); \
            if (dir == 0) { _Pragma("unroll") for (int j = 0; j < 2; ++j) S[10 + j] = *(const v4u*)(PC + ((size_t)bh * 260 + c_) * 4096 + (size_t)(ht + 256 * j) * 8); } } while (0)
#define GS_LOADK(S, n) do { const int c_ = GS_CHUNK(n); \
            const bf16* kb_ = KDT + ((((size_t)(dir * 2 + b) * 4 + h) * 260 + c_) * 256) * 64; \
            _Pragma("unroll") for (int j = 0; j < 8; ++j) S[j] = *(const v4u*)(kb_ + (size_t)(ht + 256 * j) * 8); \
            if (ht < 64) S[8] = *(const v4u*)(ET + (((size_t)(dir * 2 + b) * 4 + h) * 260 + c_) * 256 + ht * 4); } while (0)
#define GS_WRITEQ(S) do { \
            _Pragma("unroll") for (int j = 0; j < 8; ++j) { const int piece = ht + 256 * j; *(LAS v4u*)(lds + (piece >> 5) * QS + (piece & 31) * 16) = S[j]; } \
            _Pragma("unroll") for (int j = 0; j < 2; ++j) { const int piece = ht + 256 * j; *(LAS v4u*)(lds + L_V + (piece >> 3) * RS + (piece & 7) * 16) = S[8 + j]; } \
            if (dir == 0) { _Pragma("unroll") for (int j = 0; j < 2; ++j) { const int piece = ht + 256 * j; *(LAS v4u*)(lds + L_P + (piece >> 3) * RS + (piece & 7) * 16) = S[10 + j]; } } } while (0)
#define GS_WRITEK(S) do { \
            _Pragma("unroll") for (int j = 0; j < 8; ++j) { const int piece = ht + 256 * j; *(LAS v4u*)(lds + L_K + (piece >> 3) * RS + (piece & 7) * 16) = S[j]; } \
            if (ht < 64) *(LAS v4u*)(lds + L_E + ht * 16) = S[8]; } while (0)
#pragma unroll
            for (int j = 0; j < 12; ++j) { Qa[j] = (v4u){0u, 0u, 0u, 0u}; Qb[j] = (v4u){0u, 0u, 0u, 0u}; }
#pragma unroll
            for (int j = 0; j < 9; ++j) { Ka[j] = (v4u){0u, 0u, 0u, 0u}; Kb[j] = (v4u){0u, 0u, 0u, 0u}; }
            GS_LOADQ(Qa, 0); GS_LOADK(Ka, 0); GS_LOADQ(Qb, 1); GS_LOADK(Kb, 1);
            GS_WRITEQ(Qa); GS_LOADQ(Qa, 2);
            __syncthreads();
            for (int n = 0; n < 260; n += 2) {
                __syncthreads(); GS_WRITEK(Ka); if (n + 2 < 260) GS_LOADK(Ka, n + 2);
                __syncthreads(); GS_WRITEQ(Qb); if (n + 3 < 260) GS_LOADQ(Qb, n + 3);
                __syncthreads(); GS_WRITEK(Kb); if (n + 3 < 260) GS_LOADK(Kb, n + 3);
                __syncthreads(); if (n + 2 < 260) { GS_WRITEQ(Qa); } if (n + 4 < 260) GS_LOADQ(Qa, n + 4);
            }
#undef GS_LOADQ
#undef GS_LOADK
#undef GS_WRITEQ
#undef GS_WRITEK
        } else {
            bf16* O = (bf16*)(a.ws + (dir ? WS_OB : WS_OF));
            f32x4 s[16];
#pragma unroll
            for (int t = 0; t < 16; ++t) s[t] = (f32x4){0.f, 0.f, 0.f, 0.f};
            __syncthreads();
            for (int n = 0; n < 260; ++n) {
                __syncthreads();
                const int ccur = GS_CHUNK(n); const size_t row0 = (size_t)b * TB + (size_t)ccur * 64;
                bf16x8_t sa[8];
#pragma unroll
                for (int p = 0; p < 8; ++p) { const v4u w = {pk2(s[2 * p][0], s[2 * p][1]), pk2(s[2 * p][2], s[2 * p][3]), pk2(s[2 * p + 1][0], s[2 * p + 1][1]), pk2(s[2 * p + 1][2], s[2 * p + 1][3])}; sa[p] = __builtin_bit_cast(bf16x8_t, w); }
                const LAS unsigned char* vrow = lds + L_V + (16 * wave + l16) * RS + kg * 16;
                const bf16x8_t vt0 = *(const LAS bf16x8_t*)(vrow), vt1 = *(const LAS bf16x8_t*)(vrow + 64);
                const LAS unsigned char* qrow = lds + l16 * QS + kg * 16; const LAS unsigned char* prow = lds + L_P + l16 * RS + kg * 16;
                f32x4 o4[4];
#pragma unroll
                for (int tt = 0; tt < 4; ++tt) o4[tt] = (f32x4){0.f, 0.f, 0.f, 0.f};
#pragma unroll
                for (int p = 0; p < 8; ++p) {
#pragma unroll
                    for (int tt = 0; tt < 4; ++tt) { const bf16x8_t qb = *(const LAS bf16x8_t*)(qrow + tt * 16 * QS + p * 64); o4[tt] = __builtin_amdgcn_mfma_f32_16x16x32_bf16(sa[p], qb, o4[tt], 0, 0, 0); } }
                if (dir == 0) {
#pragma unroll
                    for (int tt = 0; tt < 4; ++tt) { const bf16x8_t pb0 = *(const LAS bf16x8_t*)(prow + tt * 16 * RS); o4[tt] = __builtin_amdgcn_mfma_f32_16x16x32_bf16(vt0, pb0, o4[tt], 0, 0, 0); }
#pragma unroll
                    for (int tt = 0; tt < 4; ++tt) { const bf16x8_t pb1 = *(const LAS bf16x8_t*)(prow + tt * 16 * RS + 64); o4[tt] = __builtin_amdgcn_mfma_f32_16x16x32_bf16(vt1, pb1, o4[tt], 0, 0, 0); } }
#pragma unroll
                for (int tt = 0; tt < 4; ++tt) *(v2u*)(O + (row0 + 16 * tt + l16) * 2048 + h * 512 + dvb * 64 + 16 * wave + 4 * kg) = (v2u){pk2(o4[tt][0], o4[tt][1]), pk2(o4[tt][2], o4[tt][3])};
                __syncthreads();
                const LAS unsigned char* krow = lds + L_K + l16 * RS + kg * 16; const LAS unsigned char* erow = lds + L_E + kg * 16;
#pragma unroll
                for (int t = 0; t < 16; ++t) { const bf16x8_t ka0 = *(const LAS bf16x8_t*)(krow + t * 16 * RS); s[t] = __builtin_amdgcn_mfma_f32_16x16x32_bf16(ka0, vt0, s[t], 0, 0, 0); }
#pragma unroll
                for (int t = 0; t < 16; ++t) { const bf16x8_t ka1 = *(const LAS bf16x8_t*)(krow + t * 16 * RS + 64); s[t] = __builtin_amdgcn_mfma_f32_16x16x32_bf16(ka1, vt1, s[t], 0, 0, 0); }
#pragma unroll
                for (int t = 0; t < 16; ++t) { const f32x4 et = *(const LAS f32x4*)(erow + t * 64); s[t] = s[t] * et; }
            }
        }
#undef GS_CHUNK
        __syncthreads();
    }
}

__device__ __forceinline__ void ph_gla_finish(const Args& a) {
    const int lane = threadIdx.x & 63, wave = threadIdx.x >> 6; const int gw = blockIdx.x * 8 + wave, NGW = gridDim.x * 8;
    const bf16* P = (const bf16*)(a.ws + WS_P); const bf16* OF = (const bf16*)(a.ws + WS_OF); const bf16* OB = (const bf16*)(a.ws + WS_OB);
    bf16* A2 = (bf16*)(a.ws + WS_H);
    float gn[8];
#pragma unroll
    for (int i = 0; i < 8; ++i) gn[i] = a.in[I_GGN][lane * 8 + i];
    for (int row = gw; row < MT; row += NGW) {
        v4u f[4], bb[4], gg[4];
#pragma unroll
        for (int h = 0; h < 4; ++h) { const size_t off = (size_t)row * 2048 + h * 512 + lane * 8;
            f[h] = *(const v4u*)(OF + off); bb[h] = *(const v4u*)(OB + off); gg[h] = *(const v4u*)(P + (size_t)row * N0 + 4096 + h * 512 + lane * 8); }
#pragma unroll
        for (int h = 0; h < 4; ++h) {
            float o[8], g[8];
            o[0] = bflo(f[h].x) + bflo(bb[h].x); o[1] = bfhi(f[h].x) + bfhi(bb[h].x); o[2] = bflo(f[h].y) + bflo(bb[h].y); o[3] = bfhi(f[h].y) + bfhi(bb[h].y);
            o[4] = bflo(f[h].z) + bflo(bb[h].z); o[5] = bfhi(f[h].z) + bfhi(bb[h].z); o[6] = bflo(f[h].w) + bflo(bb[h].w); o[7] = bfhi(f[h].w) + bfhi(bb[h].w);
            g[0] = bflo(gg[h].x); g[1] = bfhi(gg[h].x); g[2] = bflo(gg[h].y); g[3] = bfhi(gg[h].y); g[4] = bflo(gg[h].z); g[5] = bfhi(gg[h].z); g[6] = bflo(gg[h].w); g[7] = bfhi(gg[h].w);
            float ss = 0.f;
#pragma unroll
            for (int i = 0; i < 8; ++i) ss += o[i] * o[i];
            const float rstd = rsqrtf(wave_sum(ss) * (1.f / 512.f) + EPS);
            float y[8];
#pragma unroll
            for (int i = 0; i < 8; ++i) y[i] = o[i] * rstd * gn[i] * siluf(g[i]);
            *(v4u*)(A2 + (size_t)row * 2048 + h * 512 + lane * 8) = (v4u){pk2(y[0], y[1]), pk2(y[2], y[3]), pk2(y[4], y[5]), pk2(y[6], y[7])};
        }
    }
}

__device__ __forceinline__ float sum16(float v) { v += __shfl_xor(v, 1); v += __shfl_xor(v, 2); v += __shfl_xor(v, 4); v += __shfl_xor(v, 8); return v; }
__device__ __forceinline__ v4u qk_chunk(v4u x, const float* w8, const float* c8, const float* s8, bool lat, float sg) {
    float v[8] = {bflo(x.x), bfhi(x.x), bflo(x.y), bfhi(x.y), bflo(x.z), bfhi(x.z), bflo(x.w), bfhi(x.w)};
    float ss = 0.f;
#pragma unroll
    for (int i = 0; i < 8; ++i) ss += v[i] * v[i];
    const float rstd = rsqrtf(sum16(ss) * (1.f / 128.f) + EPS);
#pragma unroll
    for (int i = 0; i < 8; ++i) v[i] = v[i] * rstd * w8[i];
    if (lat) {
#pragma unroll
        for (int i = 0; i < 8; ++i) { const float pv = __shfl_xor(v[i], 4); v[i] = v[i] * c8[i] + sg * pv * s8[i]; }
    }
    return (v4u){pk2(v[0], v[1]), pk2(v[2], v[3]), pk2(v[4], v[5]), pk2(v[6], v[7])};
}
__device__ __forceinline__ void ph_qk_post(const Args& a) {
    const int lane = threadIdx.x & 63, wave = threadIdx.x >> 6; const int gw = blockIdx.x * 8 + wave, NGW = gridDim.x * 8;
    bf16* QD = (bf16*)(a.ws + WS_P); bf16* KD = (bf16*)(a.ws + WS_P + 130 * MiB);
    const float* ropec = (const float*)(a.ws + WS_ROPE); const float* ropes = ropec + 8192;
    const int l16 = lane & 15;
    const float sg = (l16 & 4) ? 1.f : -1.f;
    for (int item = gw; item < 2 * 32 * 1040; item += NGW) {
        const int which = item / (32 * 1040), rem = item % (32 * 1040), blk = rem / 1040, it = rem % 1040, m = blk & 1;
        if (which == 0 && it >= 1024) continue;
        bf16* base = (which ? KD : QD) + ((size_t)blk * TB + (size_t)it * 16) * 128 + lane * 8;
        const float* wsrc = (which ? a.in[I_DKN] : a.in[I_DQN]) + m * 128 + l16 * 8;
        float w8[8];
#pragma unroll
        for (int i = 0; i < 8; ++i) w8[i] = wsrc[i];
        v4u x[4];
#pragma unroll
        for (int j = 0; j < 4; ++j) x[j] = *(const v4u*)(base + j * 512);
        const bool lat = it < 1024;
#pragma unroll
        for (int j = 0; j < 4; ++j) {
            float c8[8], s8[8];
            if (lat) { const int t = it * 16 + 4 * j + (lane >> 4); const int pos = (l16 & 8) ? (t & 63) : (t >> 6);
                const float* cp = ropec + pos * 32 + (l16 & 3) * 8; const float* sp = ropes + pos * 32 + (l16 & 3) * 8;
#pragma unroll
                for (int i = 0; i < 8; ++i) { c8[i] = cp[i]; s8[i] = sp[i]; } }
            else {
#pragma unroll
                for (int i = 0; i < 8; ++i) { c8[i] = 1.f; s8[i] = 0.f; } }
            *(v4u*)(base + j * 512) = qk_chunk(x[j], w8, c8, s8, lat, sg);
        }
    }
}

__device__ __forceinline__ void ph_attn(const Args& a, unsigned char* lds) {
    const float* lv = a.in[I_DLAM];
    float d01 = 0.f, d23 = 0.f;
    for (int i = 0; i < 128; ++i) { d01 += lv[i] * lv[128 + i]; d23 += lv[256 + i] * lv[384 + i]; }
    const float lam = __expf(d01) - __expf(d23) + LAMBDA_INIT;
    float wq = 0.f, wk = 0.f;
    for (int i = 0; i < 256; ++i) { wq = fmaxf(wq, fabsf(a.in[I_DQN][i])); wk = fmaxf(wk, fabsf(a.in[I_DKN][i])); }
    const float negMc = -(attn::SCALE * 128.f * wq * wk) * 1.4426950408889634f;
    const attn::bf16* P = (const attn::bf16*)(a.ws + WS_P); float* OA = (float*)(a.ws + WS_OATT);
    const int G = gridDim.x, c = blockIdx.x;
    for (int rr = 0;; ++rr) {
        int combo, qb;
        if (G == 256) { if (rr >= 8) break; const int xs = rr * 8 + (c & 7); combo = xs >> 2; qb = (xs & 3) * 32 + (c >> 3); }
        else { const int id = rr * G + c; if (id >= 2048) break; combo = id >> 7; qb = id & 127; }
        const int b = combo >> 3, h = combo & 7;
        const attn::bf16* Q0 = P + (((size_t)(b * 8 + h) * 2) * TB + (size_t)qb * 128) * 128;
        const attn::bf16* K0 = P + (size_t)130 * MiB / 2 + ((size_t)(b * 8 + h) * 2) * TB * 128;
        const attn::bf16* V0 = P + (size_t)260 * MiB / 2 + (size_t)(b * 8 + h) * TB * 256;
        const size_t row0 = (size_t)b * TB + (size_t)qb * 128;
        unsigned short* A2w = (unsigned short*)(a.ws + WS_H) + row0 * 2048 + h * 256;
        const unsigned short* Gw = (const unsigned short*)(a.ws + WS_P + (size_t)390 * MiB) + row0 * 2048 + h * 256;
        float* O = OA + ((size_t)b * SEQ + (size_t)qb * 128) * 2048 + h * 256;
        attn::attn_ks_body<0>(Q0, K0, V0, O, A2w, Gw, a.in[I_DSUB], TB, (char*)lds, lam, negMc);
        attn::attn_ks_body<1>(Q0 + (size_t)TB * 128, K0 + (size_t)TB * 128, V0, O, A2w, Gw, a.in[I_DSUB], TB, (char*)lds, lam, negMc);
    }
}

__device__ __forceinline__ void ph_diff_finish(const Args& a) {
    const int lane = threadIdx.x & 63, wave = threadIdx.x >> 6; const int gw = blockIdx.x * 8 + wave, NGW = gridDim.x * 8;
    const bf16* P = (const bf16*)(a.ws + WS_P); const float* OA = (const float*)(a.ws + WS_OATT); bf16* A2 = (bf16*)(a.ws + WS_H);
    const f32x4 w4 = *(const f32x4*)(a.in[I_DSUB] + lane * 4);
    for (int lr = gw; lr < NB * SEQ; lr += NGW) {
        const int b = lr / SEQ, t = lr % SEQ; const size_t row = (size_t)b * TB + t;
        f32x4 o[8]; v2u gg[8];
#pragma unroll
        for (int h = 0; h < 8; ++h) { o[h] = *(const f32x4*)(OA + (size_t)lr * 2048 + h * 256 + lane * 4); gg[h] = *(const v2u*)(P + (size_t)390 * MiB / 2 + row * 2048 + h * 256 + lane * 4); }
#pragma unroll
        for (int h = 0; h < 8; ++h) {
            const float rstd = rsqrtf(wave_sum((o[h].x * o[h].x + o[h].y * o[h].y) + (o[h].z * o[h].z + o[h].w * o[h].w)) * (1.f / 256.f) + EPS) * (1.f - LAMBDA_INIT);
            const float y0 = o[h].x * rstd * w4.x * siluf(bflo(gg[h].x)), y1 = o[h].y * rstd * w4.y * siluf(bfhi(gg[h].x)), y2 = o[h].z * rstd * w4.z * siluf(bflo(gg[h].y)), y3 = o[h].w * rstd * w4.w * siluf(bfhi(gg[h].y));
            *(v2u*)(A2 + row * 2048 + h * 256 + lane * 4) = (v2u){pk2(y0, y1), pk2(y2, y3)};
        }
    }
}

#define XB_TMO      128
#define XB_XCNT(j)  (256  + 64 * (j))
#define XB_XSUB(j)  (1280 + 64 * (j))
#define XB_XGEN(j)  (2304 + 64 * (j))
#define XB_TOP      3328
#define XB_TOPGEN   3392
#define XCD_BAR_WORDS 3456
#define XB_SPIN_CAP (1u << 18)

__device__ __forceinline__ unsigned xb_ld(unsigned* p)              { return __hip_atomic_load(p, __ATOMIC_RELAXED, __HIP_MEMORY_SCOPE_AGENT); }
__device__ __forceinline__ unsigned xb_add(unsigned* p, unsigned v) { return __hip_atomic_fetch_add(p, v, __ATOMIC_RELAXED, __HIP_MEMORY_SCOPE_AGENT); }
__device__ __forceinline__ unsigned xb_xcc_id() { return (unsigned)__builtin_amdgcn_s_getreg((3 << 11) | 20) & 0xFu; }
#define XB_SPIN(cond, bar) do { unsigned _sp = 0; while (cond) { __builtin_amdgcn_s_sleep(1); \
    if ((++_sp & 255u) == 0u) { if (xb_ld(&(bar)[XB_TMO])) break; if (_sp > XB_SPIN_CAP) { atomicAdd(&(bar)[XB_TMO], 1u); break; } } } } while (0)

struct XcdBarrier {
    unsigned* bar; unsigned x;
    volatile LAS unsigned* st;
};

__device__ __forceinline__ XcdBarrier xcd_barrier_post(unsigned* bar, volatile LAS unsigned* st) {
    XcdBarrier b; b.bar = bar; b.x = xb_xcc_id(); b.st = st;
    if (threadIdx.x == 0) (void)xb_add(&bar[XB_XCNT(b.x)], 1u);
    return b;
}
__device__ __forceinline__ void xcd_barrier_complete(unsigned* bar, unsigned x, unsigned& nloc, unsigned& nx) {
    const unsigned G = gridDim.x * gridDim.y * gridDim.z;
    unsigned sum, cnt, mine, sp = 0u;
    for (;;) {
        sum = 0u; cnt = 0u; mine = 0u;
#pragma unroll
        for (unsigned j = 0; j < 16; ++j) { const unsigned c = xb_ld(&bar[XB_XCNT(j)]); sum += c; cnt += (c > 0u) ? 1u : 0u; mine = (j == x) ? c : mine; }
        if (sum == G) break;
        __builtin_amdgcn_s_sleep(1);
        if ((++sp & 255u) == 0u) { if (xb_ld(&bar[XB_TMO])) break; if (sp > XB_SPIN_CAP) { atomicAdd(&bar[XB_TMO], 1u); break; } }
    }
    nloc = mine > 0u ? mine : 1u; nx = cnt > 0u ? cnt : 1u;
}

__device__ __forceinline__ void xcd_barrier(const XcdBarrier& b) {
    asm volatile("s_waitcnt vmcnt(0)" ::: "memory");
    __syncthreads();
    if (threadIdx.x == 0) {
        unsigned* bar = b.bar;
        __builtin_amdgcn_s_waitcnt(0);
        unsigned nloc = b.st[0], nx = b.st[1];
        if (nloc == 0u) { xcd_barrier_complete(bar, b.x, nloc, nx); b.st[0] = nloc; b.st[1] = nx; }
        const unsigned old = xb_add(&bar[XB_XSUB(b.x)], 1u);
        const unsigned gen = old / nloc;
        if (old + 1u == (gen + 1u) * nloc) {
            __builtin_amdgcn_fence(__ATOMIC_RELEASE, "agent");
            asm volatile("s_waitcnt vmcnt(0)" ::: "memory");
            const unsigned og = xb_add(&bar[XB_TOP], 1u);
            const unsigned tg = og / nx;
            if (og + 1u == (tg + 1u) * nx) xb_add(&bar[XB_TOPGEN], 1u);
            else XB_SPIN(xb_ld(&bar[XB_TOPGEN]) == tg, bar);
            __builtin_amdgcn_fence(__ATOMIC_ACQUIRE, "agent");
            xb_add(&bar[XB_XGEN(b.x)], 1u);
            asm volatile("s_waitcnt vmcnt(0)" ::: "memory");
        } else {
            XB_SPIN(xb_ld(&bar[XB_XGEN(b.x)]) == gen, bar);
            __builtin_amdgcn_fence(__ATOMIC_ACQUIRE, "agent");
            asm volatile("s_waitcnt vmcnt(0)" ::: "memory");
        }
    }
    __syncthreads();
}

constexpr int NPHASE = 12;
__global__ void __launch_bounds__(512, 2) mega_fwd(Args a) {
    extern __shared__ __attribute__((aligned(16))) unsigned char lds[];
    LAS unsigned char* L = (LAS unsigned char*)lds;
    const int lo = a.ph_lo, hi = a.ph_hi;
    const int G = gridDim.x, c = blockIdx.x;
#ifndef PH_MASK
#define PH_MASK 0xFFFF
#endif
#define IN(k) (((PH_MASK >> (k)) & 1) && lo <= (k) && (k) < hi)
#define SEAM(k) do { if (IN(k) && IN((k) + 1)) { if ((k) == 0) cg::this_grid().sync(); else xcd_barrier(xbar); } } while (0)
    volatile LAS unsigned* xst = (volatile LAS unsigned*)(L + LDS_XBAR);
    if (threadIdx.x < 2) xst[threadIdx.x] = 0u;
    __syncthreads();
    XcdBarrier xbar = xcd_barrier_post((unsigned*)(a.ws + WS_BAR), xst);
    float* mods = (float*)(a.ws + WS_MODS);
    bf16* H = (bf16*)(a.ws + WS_H); bf16* P = (bf16*)(a.ws + WS_P);
    float* CTX1 = (float*)(a.ws + WS_CTX1);
    if (IN(0)) { ph_prologue(a, L); } SEAM(0);
    if (IN(1)) { ph_norm(a, 0, a.in[I_X], a.in[I_CTX]); } SEAM(1);
    if (IN(2)) { pg8::Gemm g{H, (const bf16*)(a.ws + WS_WT0), MT, N0P, 2048}; pg8::StaticOrder S; S.init(MT, N0P, G, c);
        pg8::EpiIn E{P, N0, N0, (float*)(a.ws + WS_R), 1024, 0.0625f};
        pg8::gemm_phase<pg8::EpiIn, pg8::StaticOrder, true, true>(L, g, S, E); } SEAM(2);
    if (IN(3)) { ph_gla_pre(a, L); } SEAM(3);
    if (IN(4)) { ph_gla_scan(a, L); } SEAM(4);
    if (IN(5)) { ph_gla_finish(a); } SEAM(5);
    if (IN(6)) { pg8::Gemm g{H, (const bf16*)(a.ws + WS_WT1), MT, 2048, 2048}; pg8::StaticOrder S; S.init(MT, 2048, G, c);
        pg8::EpiOut E{a.in[I_X], a.out, a.in[I_CTX], CTX1, mods};
        pg8::gemm_phase<pg8::EpiOut, pg8::StaticOrder, true, true>(L, g, S, E); } SEAM(6);
    if (IN(7)) { ph_norm(a, 1, a.out, CTX1); } SEAM(7);
    if (IN(8)) { pg8::Gemm g{H, (const bf16*)(a.ws + WS_WT2), MT, N1, 2048}; pg8::StaticOrder S; S.init(MT, N1, G, c);
        pg8::EpiInD E{P, P + (size_t)130 * MiB / 2, P + (size_t)260 * MiB / 2, P + (size_t)390 * MiB / 2};
        pg8::gemm_phase<pg8::EpiInD, pg8::StaticOrder, true, true>(L, g, S, E); } SEAM(8);
    if (IN(9)) { ph_qk_post(a); } SEAM(9);
    if (IN(10)) { ph_attn(a, lds); } SEAM(10);
    if (IN(11)) { pg8::Gemm g{H, (const bf16*)(a.ws + WS_WT3), MT, 2048, 2048}; pg8::LatentOrder S; S.init(G, c);
        pg8::EpiOut E{a.out, a.out, nullptr, nullptr, mods + 3 * 6144};
        pg8::gemm_phase<pg8::EpiOut, pg8::LatentOrder, true, true>(L, g, S, E); }
#undef IN
#undef SEAM
}

extern "C" void kernel_launch(void* const* d_in, const int* in_sizes, int n_in, void* d_out, int out_size, void* d_ws, size_t ws_size, hipStream_t stream) {
    static int grid = 0;
    if (grid == 0) {
        if (n_in != 19 || out_size != NB * SEQ * DM || ws_size < WS_END) { fprintf(stderr, "kernel_launch: unexpected shapes: n_in %d out %d ws %zu (need %zu)\n", n_in, out_size, ws_size, (size_t)WS_END); grid = -1; return; }
        int dev = 0, cus = 0, per_cu = 0;
        hipGetDevice(&dev); hipDeviceGetAttribute(&cus, hipDeviceAttributeMultiprocessorCount, dev);
        if (hipFuncSetAttribute((const void*)mega_fwd, hipFuncAttributeMaxDynamicSharedMemorySize, LDS_BYTES) != hipSuccess) { fprintf(stderr, "kernel_launch: hipFuncSetAttribute failed\n"); grid = -1; return; }
        if (hipOccupancyMaxActiveBlocksPerMultiprocessor(&per_cu, (const void*)mega_fwd, 512, LDS_BYTES) != hipSuccess || per_cu < 1) { fprintf(stderr, "kernel_launch: occupancy query says %d\n", per_cu); per_cu = 1; }
        (void)hipGetLastError();
        grid = cus * per_cu;
        fprintf(stderr, "kernel_launch: grid %d (cus %d x %d), ws %zu\n", grid, cus, per_cu, ws_size);
    }
    if (grid < 0) return;
    hipMemsetAsync((char*)d_ws + WS_MODS, 0, CTL_ZERO_BYTES, stream);
    Args a{};
    for (int i = 0; i < 19; ++i) a.in[i] = (const float*)d_in[i];
    a.out = (float*)d_out; a.ws = (unsigned char*)d_ws;
#ifdef PROBE_RANGES
    { const int rg[] = PROBE_RANGES; for (unsigned k = 0; k + 1 < sizeof(rg) / sizeof(int); k += 2) { a.ph_lo = rg[k]; a.ph_hi = rg[k + 1]; void* args[] = {&a};
        hipError_t e = hipLaunchCooperativeKernel((const void*)mega_fwd, dim3(grid), dim3(512), args, LDS_BYTES, stream);
        if (e != hipSuccess) fprintf(stderr, "kernel_launch: cooperative launch failed: %s (grid %d)\n", hipGetErrorString(e), grid); } }
#else
    a.ph_lo = 0; a.ph_hi = NPHASE;
    void* args[] = {&a};
    hipError_t e = hipLaunchCooperativeKernel((const void*)mega_fwd, dim3(grid), dim3(512), args, LDS_BYTES, stream);
    if (e != hipSuccess) fprintf(stderr, "kernel_launch: cooperative launch failed: %s (grid %d)\n", hipGetErrorString(e), grid);
#endif
}
```
